# Optimizing an MI355X kernel written in HIP

```python
import math
import jax, jax.numpy as jnp
from jax import lax
import numpy as np

D_MODEL = 1024
BATCH = 2
SEQ = 16384
DEPTH = 2

PLE_DIM = 256
D_FF = 4 * D_MODEL
NORM_EPS = 1e-6
ROPE_THETA = 500000.0
ROPE_FRACTION = 4
Q_BLOCK = 128

SB_HEADS = 8
SB_HEAD_DIM = 64
DIFF_HEADS = 4
DIFF_HEAD_DIM = 64
DIFF_V_DIM = 2 * DIFF_HEAD_DIM
SB_WIDTH = SB_HEADS * SB_HEAD_DIM
DIFF_QK_WIDTH = DIFF_HEADS * 2 * DIFF_HEAD_DIM
DIFF_V_WIDTH = DIFF_HEADS * DIFF_V_DIM
EVEN_IN_WIDTH = 3 * SB_WIDTH + 2 * DIFF_QK_WIDTH + DIFF_V_WIDTH
EVEN_OUT_WIDTH = SB_WIDTH + DIFF_V_WIDTH

MOBA_HEADS = 16
MOBA_HEAD_DIM = 64
MOBA_WIDTH = MOBA_HEADS * MOBA_HEAD_DIM
MOBA_BLOCK = 256
MOBA_TOPK = 3
MOBA_Q_CHUNK = 64

N_EVEN = (DEPTH + 1) // 2
N_ODD = DEPTH // 2

kernel_name = "hybrid_stickbreak_diff_moba_trunk"


def rms_norm(x, g):
    xf = x.astype(jnp.float32)
    y = xf * lax.rsqrt(jnp.mean(xf * xf, axis=-1, keepdims=True) + NORM_EPS)
    return (y * g.astype(jnp.float32)).astype(x.dtype)


def rope_tables(positions, head_dim):
    rot = head_dim // ROPE_FRACTION
    inv_freq = ROPE_THETA ** (-(jnp.arange(0, rot, 2, dtype=jnp.float32) / rot))
    ang = positions.astype(jnp.float32)[..., None] * inv_freq
    return jnp.cos(ang), jnp.sin(ang)


def apply_partial_rope(x, cos, sin):
    half = cos.shape[-1]
    rot = 2 * half
    c = cos[:, :, None, :]
    s = sin[:, :, None, :]
    x1 = x[..., :half].astype(jnp.float32)
    x2 = x[..., half:rot].astype(jnp.float32)
    r = jnp.concatenate([x1 * c - x2 * s, x1 * s + x2 * c], axis=-1).astype(x.dtype)
    return jnp.concatenate([r, x[..., rot:]], axis=-1)


def to_heads(t, n_heads):
    b, s, _ = t.shape
    return t.reshape(b, s, n_heads, -1).transpose(0, 2, 1, 3)


def from_heads(t):
    b, h, s, d = t.shape
    return t.transpose(0, 2, 1, 3).reshape(b, s, h * d)


def stick_breaking_attention(q, k, v):
    B, H, S, d = q.shape
    nqb = S // Q_BLOCK
    scale = d ** -0.5
    kpos = jnp.arange(S)
    qb = q.reshape(B, H, nqb, Q_BLOCK, d).transpose(2, 0, 1, 3, 4)

    def one_block(args):
        qi, bi = args
        qpos = bi * Q_BLOCK + jnp.arange(Q_BLOCK)
        z = jnp.einsum('bhqd,bhkd->bhqk', qi, k).astype(jnp.float32) * scale
        past = kpos[None, :] < qpos[:, None]
        log_keep = jnp.where(past, jax.nn.log_sigmoid(-z), 0.0)
        tail = lax.cumsum(log_keep, axis=3, reverse=True) - log_keep
        w = jnp.where(past, jnp.exp(jax.nn.log_sigmoid(z) + tail), 0.0)
        return jnp.einsum('bhqk,bhkd->bhqd', w.astype(v.dtype), v)

    out = lax.map(one_block, (qb, jnp.arange(nqb)))
    return out.transpose(1, 2, 0, 3, 4).reshape(B, H, S, d)


def diff_attention(q1, q2, k1, k2, v, lam):
    B, H, S, d = q1.shape
    nqb = S // Q_BLOCK
    scale = d ** -0.5
    kpos = jnp.arange(S)
    q1b = q1.reshape(B, H, nqb, Q_BLOCK, d).transpose(2, 0, 1, 3, 4)
    q2b = q2.reshape(B, H, nqb, Q_BLOCK, d).transpose(2, 0, 1, 3, 4)
    lam_b = lam[None, :, None, None]

    def one_block(args):
        q1i, q2i, bi = args
        qpos = bi * Q_BLOCK + jnp.arange(Q_BLOCK)
        causal = kpos[None, :] <= qpos[:, None]

        def probs(qi, ki):
            s = jnp.einsum('bhqd,bhkd->bhqk', qi, ki).astype(jnp.float32) * scale
            return jax.nn.softmax(jnp.where(causal, s, -jnp.inf), axis=-1)

        a = probs(q1i, k1) - lam_b * probs(q2i, k2)
        return jnp.einsum('bhqk,bhkd->bhqd', a.astype(v.dtype), v)

    out = lax.map(one_block, (q1b, q2b, jnp.arange(nqb)))
    return out.transpose(1, 2, 0, 3, 4).reshape(B, H, S, v.shape[-1])


def moba_attention(q, k, v):
    B, H, S, d = q.shape
    nb = -(-S // MOBA_BLOCK)
    pad = nb * MOBA_BLOCK - S
    kp = jnp.pad(k, ((0, 0), (0, 0), (0, pad), (0, 0)))
    vp = jnp.pad(v, ((0, 0), (0, 0), (0, pad), (0, 0)))
    kblk = kp.reshape(B, H, nb, MOBA_BLOCK, d)
    vblk = vp.reshape(B, H, nb, MOBA_BLOCK, d)
    kmean = kblk.mean(axis=3)
    n_sel = min(MOBA_TOPK, nb)
    nqc = S // MOBA_Q_CHUNK
    scale = d ** -0.5
    qc = q.reshape(B, H, nqc, MOBA_Q_CHUNK, d).transpose(2, 0, 1, 3, 4)
    blk_ids = jnp.arange(nb)
    bidx = jnp.arange(B)[:, None, None, None]
    hidx = jnp.arange(H)[None, :, None, None]

    def one_chunk(args):
        qi, ci = args
        q0 = ci * MOBA_Q_CHUNK
        own = q0 // MOBA_BLOCK
        qpos = q0 + jnp.arange(MOBA_Q_CHUNK)
        gate = jnp.einsum('bhqd,bhnd->bhqn', qi, kmean).astype(jnp.float32)
        gate = jnp.where(blk_ids < own, gate, -jnp.inf)
        _, gidx = lax.top_k(gate, n_sel)
        sel_valid = gidx < own
        ksel = kblk[bidx, hidx, gidx]
        vsel = vblk[bidx, hidx, gidx]
        s_sel = jnp.einsum('bhqd,bhqnkd->bhqnk', qi, ksel).astype(jnp.float32) * scale
        s_sel = jnp.where(sel_valid[..., None], s_sel, -jnp.inf)
        s_sel = s_sel.reshape(B, H, MOBA_Q_CHUNK, n_sel * MOBA_BLOCK)
        k_own = lax.dynamic_slice_in_dim(kp, own * MOBA_BLOCK, MOBA_BLOCK, axis=2)
        v_own = lax.dynamic_slice_in_dim(vp, own * MOBA_BLOCK, MOBA_BLOCK, axis=2)
        own_pos = own * MOBA_BLOCK + jnp.arange(MOBA_BLOCK)
        s_own = jnp.einsum('bhqd,bhkd->bhqk', qi, k_own).astype(jnp.float32) * scale
        s_own = jnp.where(own_pos[None, :] <= qpos[:, None], s_own, -jnp.inf)
        probs = jax.nn.softmax(jnp.concatenate([s_sel, s_own], axis=-1), axis=-1)
        p_sel = probs[..., :n_sel * MOBA_BLOCK].reshape(B, H, MOBA_Q_CHUNK, n_sel, MOBA_BLOCK)
        p_own = probs[..., n_sel * MOBA_BLOCK:]
        return (jnp.einsum('bhqnk,bhqnkd->bhqd', p_sel.astype(v.dtype), vsel)
                + jnp.einsum('bhqk,bhkd->bhqd', p_own.astype(v.dtype), v_own))

    out = lax.map(one_chunk, (qc, jnp.arange(nqc)))
    return out.transpose(1, 2, 0, 3, 4).reshape(B, H, S, d)


def even_mixer(u, w_in, w_out, lq1, lk1, lq2, lk2, subln_g, cos, sin, layer_idx):
    B, S, _ = u.shape
    proj = u @ w_in
    cuts = list(np.cumsum([SB_WIDTH, SB_WIDTH, SB_WIDTH, DIFF_QK_WIDTH, DIFF_QK_WIDTH]))
    a_q, a_k, a_v, b_q, b_k, b_v = jnp.split(proj, [int(c) for c in cuts], axis=-1)
    o_a = stick_breaking_attention(to_heads(a_q, SB_HEADS), to_heads(a_k, SB_HEADS),
                                   to_heads(a_v, SB_HEADS))
    bq = b_q.reshape(B, S, DIFF_HEADS, 2, DIFF_HEAD_DIM)
    bk = b_k.reshape(B, S, DIFF_HEADS, 2, DIFF_HEAD_DIM)
    rq = lambda t: apply_partial_rope(t, cos, sin).transpose(0, 2, 1, 3)
    q1, q2 = rq(bq[..., 0, :]), rq(bq[..., 1, :])
    k1, k2 = rq(bk[..., 0, :]), rq(bk[..., 1, :])
    lam_init = 0.8 - 0.6 * math.exp(-0.3 * layer_idx)
    f32 = jnp.float32
    lam = (jnp.exp(jnp.sum(lq1.astype(f32) * lk1.astype(f32), axis=-1))
           - jnp.exp(jnp.sum(lq2.astype(f32) * lk2.astype(f32), axis=-1)) + lam_init)
    o_b = diff_attention(q1, q2, k1, k2, to_heads(b_v, DIFF_HEADS), lam)
    o_b = rms_norm(o_b, subln_g) * (1.0 - lam_init)
    merged = jnp.concatenate([from_heads(o_a), from_heads(o_b)], axis=-1)
    return merged @ w_out


def odd_mixer(u, w_in, w_out, cos, sin):
    B, S, _ = u.shape
    q, k, v = jnp.split(u @ w_in, 3, axis=-1)
    q = apply_partial_rope(q.reshape(B, S, MOBA_HEADS, MOBA_HEAD_DIM), cos, sin).transpose(0, 2, 1, 3)
    k = apply_partial_rope(k.reshape(B, S, MOBA_HEADS, MOBA_HEAD_DIM), cos, sin).transpose(0, 2, 1, 3)
    o = moba_attention(q, k, to_heads(v, MOBA_HEADS))
    return from_heads(o) @ w_out


def squared_relu_mlp(u, w1, w2):
    return jnp.square(jax.nn.relu(u @ w1)) @ w2


def setup_inputs(seed: int = 0) -> dict:
    key = jax.random.key(seed)
    ks = jax.random.split(key, 24)
    f32 = jnp.float32
    nrm = lambda k, shape, fan_in: jax.random.normal(k, shape, f32) * (fan_in ** -0.5)
    gain = lambda k, shape: 1.0 + 0.01 * jax.random.normal(k, shape, f32)
    x = jax.random.normal(ks[0], (BATCH, SEQ, D_MODEL), f32)
    p = jax.random.normal(ks[1], (DEPTH, BATCH, SEQ, PLE_DIM), f32)
    offsets = jax.random.randint(ks[2], (BATCH, 1), 0, 4096, dtype=jnp.int32)
    positions = (offsets + jnp.arange(SEQ, dtype=jnp.int32)[None, :]).astype(jnp.int32)
    return {
        "x": x,
        "p": p,
        "positions": positions,
        "attn_norm": gain(ks[3], (DEPTH, D_MODEL)),
        "ab_w_in": nrm(ks[4], (N_EVEN, D_MODEL, EVEN_IN_WIDTH), D_MODEL),
        "ab_w_out": nrm(ks[5], (N_EVEN, EVEN_OUT_WIDTH, D_MODEL), EVEN_OUT_WIDTH),
        "diff_lam_q1": 0.1 * jax.random.normal(ks[6], (N_EVEN, DIFF_HEADS, DIFF_HEAD_DIM), f32),
        "diff_lam_k1": 0.1 * jax.random.normal(ks[7], (N_EVEN, DIFF_HEADS, DIFF_HEAD_DIM), f32),
        "diff_lam_q2": 0.1 * jax.random.normal(ks[8], (N_EVEN, DIFF_HEADS, DIFF_HEAD_DIM), f32),
        "diff_lam_k2": 0.1 * jax.random.normal(ks[9], (N_EVEN, DIFF_HEADS, DIFF_HEAD_DIM), f32),
        "diff_subln": gain(ks[10], (N_EVEN, DIFF_V_DIM)),
        "moba_w_in": nrm(ks[11], (N_ODD, D_MODEL, 3 * MOBA_WIDTH), D_MODEL),
        "moba_w_out": nrm(ks[12], (N_ODD, MOBA_WIDTH, D_MODEL), MOBA_WIDTH),
        "mlp_norm": gain(ks[13], (DEPTH, D_MODEL)),
        "w_ff1": nrm(ks[14], (DEPTH, D_MODEL, D_FF), D_MODEL),
        "w_ff2": nrm(ks[15], (DEPTH, D_FF, D_MODEL), D_FF),
        "ple_norm": gain(ks[16], (DEPTH, D_MODEL)),
        "ple_gate": nrm(ks[17], (DEPTH, D_MODEL, D_MODEL), D_MODEL),
        "ple_proj": nrm(ks[18], (DEPTH, PLE_DIM, D_MODEL), PLE_DIM),
        "final_norm": gain(ks[19], (D_MODEL,)),
    }


def reference(x, p, positions, attn_norm, ab_w_in, ab_w_out, diff_lam_q1, diff_lam_k1,
              diff_lam_q2, diff_lam_k2, diff_subln, moba_w_in, moba_w_out, mlp_norm,
              w_ff1, w_ff2, ple_norm, ple_gate, ple_proj, final_norm):
    cos, sin = rope_tables(positions, DIFF_HEAD_DIM)
    h = x
    for i in range(DEPTH):
        u = rms_norm(h, attn_norm[i])
        if i % 2 == 0:
            j = i // 2
            mix = even_mixer(u, ab_w_in[j], ab_w_out[j], diff_lam_q1[j], diff_lam_k1[j],
                             diff_lam_q2[j], diff_lam_k2[j], diff_subln[j], cos, sin, i)
        else:
            j = i // 2
            mix = odd_mixer(u, moba_w_in[j], moba_w_out[j], cos, sin)
        h = h + mix
        h = h + squared_relu_mlp(rms_norm(h, mlp_norm[i]), w_ff1[i], w_ff2[i])
        gate = jax.nn.sigmoid(rms_norm(h, ple_norm[i]) @ ple_gate[i])
        h = h + gate * (p[i].astype(h.dtype) @ ple_proj[i])
    return rms_norm(h, final_norm)
```

```cpp
#include <hip/hip_runtime.h>
#include <hip/hip_cooperative_groups.h>
#include <cstdio>
#include <cstdint>
namespace cg = cooperative_groups;
namespace pg8 {
#define PG8_LAS __attribute__((address_space(3)))
typedef unsigned short bf16_t;
typedef short bf16x8 __attribute__((ext_vector_type(8)));
typedef float f32x4 __attribute__((ext_vector_type(4)));
typedef unsigned u32x4 __attribute__((ext_vector_type(4)));
constexpr int BM = 256, BK = 64, HALF = 128, HTB = HALF * BK * 2  , STAGE_BYTES = 8 * HTB, NXCD = 8, WGM = 8;

__host__ __device__ __forceinline__ int lds_byte(int r, int c) { const int st = (r >> 4) * 2 + (c >> 5), rr = r & 15, cc = c & 31, ob = rr * 64 + cc * 2; return st * 1024 + (ob ^ (((ob >> 9) & 1) << 5)); }
__host__ __device__ __forceinline__ void stage_rc(int b, int& R, int& C) { const int st = b / 1024, sb = b % 1024, swz = sb ^ (((sb >> 9) & 1) << 5); R = (st >> 1) * 16 + swz / 64; C = (st & 1) * 32 + (swz % 64) / 2; }
__host__ __device__ __forceinline__ int perm32(int rho) { const int n = rho >> 4, i = rho & 15; return 8 * (i >> 2) + 4 * n + (i & 3); }

struct Unit { int pm, pn; };
struct Gemm { const bf16_t* A; const bf16_t* Bt; int M, N, K; };

struct StaticOrder {
    int nM, nN, nwg, G, c;
    __host__ __device__ void init(int M, int N, int G_, int c_) { nM = M / BM; nN = N / BM; nwg = nM * nN; G = G_; c = c_; }
    __host__ __device__ bool next(int i, Unit& u) const {
        const long L = (long)i * G + c; if (L >= nwg) return false;
        int wgid = (int)L; { const int q = nwg / NXCD, r = nwg % NXCD, xcd = wgid % NXCD, off = wgid / NXCD; wgid = (xcd < r ? xcd * (q + 1) : r * (q + 1) + (xcd - r) * q) + off; }
        const int nig = WGM * nN, gid = wgid / nig, fm = gid * WGM, gsz = (nM - fm) < WGM ? (nM - fm) : WGM;
        u.pm = fm + ((wgid % nig) % gsz); u.pn = (wgid % nig) / gsz; return true;
    }
    __device__ __forceinline__ void a_ready(const Unit&) const {}
    __device__ __forceinline__ void done(const Unit&) const {}
};

__device__ __forceinline__ unsigned cvt_pk_bf16(float lo, float hi) { unsigned r; asm volatile("v_cvt_pk_bf16_f32 %0, %1, %2" : "=v"(r) : "v"(lo), "v"(hi)); return r; }
typedef float f32x2 __attribute__((ext_vector_type(2)));
template <class Epi, class Sched, bool ALIGN_EPI = false, bool SP2 = false>
__device__ __forceinline__ void gemm_phase(PG8_LAS unsigned char* lds, const Gemm g, const Sched& S, const Epi& E) {
    int tid_ = threadIdx.x; asm volatile("" : "+v"(tid_)); const int tid = tid_, wid = __builtin_amdgcn_readfirstlane(tid >> 6), lane = tid & 63, wr = wid >> 2, wc = wid & 3, fr = lane & 15, fq = lane >> 4;
    const int K = g.K, nt = K / BK;
    unsigned voffA[2], voffB[2];
#pragma unroll
    for (int i = 0; i < 2; ++i) { int R, C; stage_rc(tid * 16 + i * 8192, R, C); const int Rb = Epi::PERM ? ((R & ~31) + perm32(R & 31)) : R;
        voffA[i] = (unsigned)(R * K + C) * 2u; voffB[i] = (unsigned)(Rb * K + C) * 2u; }
    const size_t kstep = (size_t)(BK * 2);
    const size_t hstep = (size_t)HALF * K * 2;
    const size_t tstep = 2 * hstep;
    const unsigned ldsw = (unsigned)wid * 1024u;
    const int aoff = lds_byte(wr * 64 + fr, fq * 8), boff = lds_byte(wc * 32 + fr, fq * 8);
#define PG8_SA(b, h) (((b) * 2 + (h)) * HTB)
#define PG8_SB(b, h) ((4 + (b) * 2 + (h)) * HTB)
#define PG8_STAGE(bufoff, gbase, voff) do { _Pragma("unroll") for (int _i = 0; _i < 2; ++_i) \
        __builtin_amdgcn_global_load_lds((const unsigned*)((const char*)(gbase) + (voff)[_i]), (PG8_LAS unsigned*)(lds + (bufoff) + ldsw + _i * 8192), 16, 0, 0); } while (0)
#define PG8_LDA(dst, b, h) do { _Pragma("unroll") for (int m = 0; m < 4; ++m) _Pragma("unroll") for (int k = 0; k < 2; ++k) dst[m][k] = *(const PG8_LAS bf16x8*)(lds + PG8_SA(b, h) + aoff + m * 2048 + k * 1024); } while (0)
#define PG8_LDB(dst, b, h) do { _Pragma("unroll") for (int n = 0; n < 2; ++n) _Pragma("unroll") for (int k = 0; k < 2; ++k) dst[n][k] = *(const PG8_LAS bf16x8*)(lds + PG8_SB(b, h) + boff + n * 2048 + k * 1024); } while (0)
#define PG8_MMA(ai, bj, At, Bt) do { __builtin_amdgcn_s_setprio(1); _Pragma("unroll") for (int m = 0; m < 4; ++m) _Pragma("unroll") for (int n = 0; n < 2; ++n) _Pragma("unroll") for (int k = 0; k < 2; ++k) \
        acc[ai][bj][m][n] = __builtin_amdgcn_mfma_f32_16x16x32_bf16(Bt[n][k], At[m][k], acc[ai][bj][m][n], 0, 0, 0); __builtin_amdgcn_s_setprio(0); } while (0)
#define PG8_WAIT_V(n) asm volatile("s_waitcnt vmcnt(" #n ")" ::: "memory")
#define PG8_WAIT_L(n) asm volatile("s_waitcnt lgkmcnt(" #n ")" ::: "memory")
#define PG8_BAR __builtin_amdgcn_s_barrier()
#define PG8_SCHED __builtin_amdgcn_sched_barrier(0)
    Unit cur, nxt; int ui = 0;
    if (!S.next(0, cur)) return;
    f32x4 acc[2][2][4][2];
#pragma unroll
    for (int a = 0; a < 2; ++a)
#pragma unroll
        for (int b = 0; b < 2; ++b)
#pragma unroll
            for (int m = 0; m < 4; ++m)
#pragma unroll
                for (int n = 0; n < 2; ++n) acc[a][b][m][n] = (f32x4){0.f, 0.f, 0.f, 0.f};
    bf16x8 At[4][2], B0[2][2], B1[2][2];
    const char* cA = (const char*)g.A + (size_t)cur.pm * tstep; const char* cB = (const char*)g.Bt + (size_t)cur.pn * tstep;
    S.a_ready(cur);
    if constexpr (SP2) {
        PG8_STAGE(PG8_SB(0, 0), cB, voffB); PG8_STAGE(PG8_SB(0, 1), cB + hstep, voffB); PG8_STAGE(PG8_SA(0, 0), cA, voffA); PG8_STAGE(PG8_SA(0, 1), cA + hstep, voffA);
        if (wr == 1) PG8_BAR;
        PG8_WAIT_V(2); PG8_BAR;
        PG8_STAGE(PG8_SB(1, 0), cB + kstep, voffB); PG8_STAGE(PG8_SA(1, 0), cA + kstep, voffA); PG8_STAGE(PG8_SB(1, 1), cB + hstep + kstep, voffB);
        PG8_WAIT_V(6); PG8_BAR;
    } else {
        PG8_STAGE(PG8_SB(0, 0), cB, voffB); PG8_STAGE(PG8_SA(0, 0), cA, voffA); PG8_STAGE(PG8_SB(0, 1), cB + hstep, voffB); PG8_STAGE(PG8_SA(0, 1), cA + hstep, voffA);
        if (wr == 1) PG8_BAR;
        PG8_WAIT_V(4); PG8_BAR;
        PG8_STAGE(PG8_SB(1, 0), cB + kstep, voffB); PG8_STAGE(PG8_SA(1, 0), cA + kstep, voffA); PG8_STAGE(PG8_SB(1, 1), cB + hstep + kstep, voffB);
        PG8_WAIT_V(6); PG8_BAR;
    }
    for (;;) {
        const bool has_next = S.next(ui + 1, nxt);
        const char* nA = has_next ? (const char*)g.A + (size_t)nxt.pm * tstep : cA; const char* nB = has_next ? (const char*)g.Bt + (size_t)nxt.pn * tstep : cB;
        for (int t = 0; t < nt; t += 2) {
            const bool last = (t == nt - 2);
            const char* a1 = cA + (size_t)(t + 1) * kstep;
            const char* a2 = last ? nA : cA + (size_t)(t + 2) * kstep; const char* b2 = last ? nB : cB + (size_t)(t + 2) * kstep;
            const char* a3 = a2 + kstep; const char* b3 = b2 + kstep;
            if (last && has_next) S.a_ready(nxt);
            if constexpr (SP2) {
            PG8_LDB(B0, 0, 0); PG8_LDB(B1, 0, 1); PG8_SCHED; PG8_LDA(At, 0, 0); PG8_STAGE(PG8_SA(1, 1), a1 + hstep, voffA);
            PG8_WAIT_V(8); PG8_WAIT_L(0); PG8_BAR; PG8_MMA(0, 0, At, B0); PG8_MMA(0, 1, At, B1); PG8_BAR; PG8_SCHED;
            PG8_LDA(At, 0, 1); PG8_STAGE(PG8_SB(0, 0), b2, voffB); PG8_STAGE(PG8_SB(0, 1), b2 + hstep, voffB); PG8_STAGE(PG8_SA(0, 0), a2, voffA);
            PG8_WAIT_V(8); PG8_WAIT_L(0); PG8_BAR; PG8_MMA(1, 0, At, B0); PG8_MMA(1, 1, At, B1); PG8_BAR; PG8_SCHED;
            PG8_LDB(B0, 1, 0); PG8_LDB(B1, 1, 1); PG8_SCHED; PG8_LDA(At, 1, 0); PG8_STAGE(PG8_SA(0, 1), a2 + hstep, voffA);
            PG8_WAIT_V(8); PG8_WAIT_L(0); PG8_BAR; PG8_MMA(0, 0, At, B0); PG8_MMA(0, 1, At, B1); PG8_BAR; PG8_SCHED;
            PG8_LDA(At, 1, 1); PG8_STAGE(PG8_SB(1, 0), b3, voffB); PG8_STAGE(PG8_SB(1, 1), b3 + hstep, voffB); PG8_STAGE(PG8_SA(1, 0), a3, voffA);
            PG8_WAIT_V(8); PG8_WAIT_L(0); PG8_BAR; PG8_MMA(1, 0, At, B0); PG8_MMA(1, 1, At, B1); PG8_BAR; PG8_SCHED;
            } else {
            PG8_LDB(B0, 0, 0); PG8_SCHED; PG8_LDA(At, 0, 0); PG8_STAGE(PG8_SA(1, 1), a1 + hstep, voffA);
            PG8_WAIT_L(8); PG8_BAR; PG8_WAIT_L(0); PG8_MMA(0, 0, At, B0); PG8_BAR; PG8_SCHED;
            PG8_LDB(B1, 0, 1); PG8_STAGE(PG8_SB(0, 0), b2, voffB);
            PG8_BAR; PG8_WAIT_L(0); PG8_MMA(0, 1, At, B1); PG8_BAR;
            PG8_LDA(At, 0, 1); PG8_STAGE(PG8_SA(0, 0), a2, voffA);
            PG8_BAR; PG8_WAIT_L(0); PG8_MMA(1, 0, At, B0); PG8_BAR; PG8_SCHED;
            PG8_STAGE(PG8_SB(0, 1), b2 + hstep, voffB);
            PG8_WAIT_V(6); PG8_BAR; PG8_MMA(1, 1, At, B1); PG8_BAR;
            PG8_LDB(B0, 1, 0); PG8_SCHED; PG8_LDA(At, 1, 0); PG8_STAGE(PG8_SA(0, 1), a2 + hstep, voffA);
            PG8_WAIT_L(8); PG8_BAR; PG8_WAIT_L(0); PG8_MMA(0, 0, At, B0); PG8_BAR; PG8_SCHED;
            PG8_LDB(B1, 1, 1); PG8_STAGE(PG8_SB(1, 0), b3, voffB);
            PG8_BAR; PG8_WAIT_L(0); PG8_MMA(0, 1, At, B1); PG8_BAR;
            PG8_LDA(At, 1, 1); PG8_STAGE(PG8_SA(1, 0), a3, voffA);
            PG8_BAR; PG8_WAIT_L(0); PG8_MMA(1, 0, At, B0); PG8_BAR; PG8_SCHED;
            PG8_STAGE(PG8_SB(1, 1), b3 + hstep, voffB);
            PG8_WAIT_V(6); PG8_BAR; PG8_MMA(1, 1, At, B1); PG8_BAR;
            }
        }
        if constexpr (ALIGN_EPI) { if (wr == 0) PG8_BAR; }
        if constexpr (!Epi::AFTER_DRAIN) { E(acc, cur, wr, wc, fr, fq); S.done(cur); }
        if (!has_next) break;
#pragma unroll
        for (int a = 0; a < 2; ++a)
#pragma unroll
            for (int b = 0; b < 2; ++b)
#pragma unroll
                for (int m = 0; m < 4; ++m)
#pragma unroll
                    for (int n = 0; n < 2; ++n) acc[a][b][m][n] = (f32x4){0.f, 0.f, 0.f, 0.f};
        cur = nxt; cA = nA; cB = nB; ++ui;
        if constexpr (ALIGN_EPI) { if (wr == 1) PG8_BAR; }
    }
    PG8_WAIT_V(0);
    if constexpr (!ALIGN_EPI) { if (wr == 0) PG8_BAR; }
    PG8_BAR;
    if constexpr (Epi::AFTER_DRAIN) { E.fused(acc, cur, wr, wc, fr, fq, lds, wid, lane); S.done(cur); }
#undef PG8_SA
#undef PG8_SB
#undef PG8_STAGE
#undef PG8_LDA
#undef PG8_LDB
#undef PG8_MMA
#undef PG8_WAIT_V
#undef PG8_WAIT_L
#undef PG8_BAR
#undef PG8_SCHED
}
}

#define DI __device__ __forceinline__
#define LAS __attribute__((address_space(3)))
typedef unsigned short bf16_t;
typedef short bf16x8 __attribute__((ext_vector_type(8)));
typedef short s16x4 __attribute__((ext_vector_type(4)));
typedef short v4i16_t __attribute__((ext_vector_type(4)));
typedef float f32x4 __attribute__((ext_vector_type(4)));
typedef float f32x16 __attribute__((ext_vector_type(16)));
typedef unsigned u32x4 __attribute__((ext_vector_type(4)));
typedef unsigned u32x2 __attribute__((ext_vector_type(2)));

constexpr int BATCH = 2, SEQ = 16384, DM = 1024, NT = BATCH * SEQ, FF = 4096, PLE = 256, QKVW = 3072;
constexpr int NWAVES = 8, NTHR = 512;
constexpr float NORM_EPS = 1e-6f;
constexpr float LOG2E = 1.4426950408889634f;
constexpr float SCL2 = 0.125f * LOG2E;
constexpr size_t MiB = 1u << 20;
constexpr size_t WS_CTL = 0, CTL_BYTES = 65536, CTL_BAR_OFF = 16384;
constexpr size_t WS_WL1 = 1 * MiB, WS_ROPE = 28 * MiB, WS_PB1 = 30 * MiB, WS_KM = 46 * MiB, WS_SEL = 47 * MiB, WS_PML = 49 * MiB;
constexpr size_t WS_QKV = 64 * MiB, WS_ATT = 256 * MiB, WS_HID = 64 * MiB, WS_PP = 64 * MiB, WS_U = 320 * MiB;
constexpr size_t WS_PA = 61 * MiB, WS_PB = 46 * MiB;
constexpr size_t WS_WL0 = 384 * MiB, WS_PB0 = 412 * MiB, WS_PO = 320 * MiB, WS_END = 512 * MiB;
constexpr size_t WO_IN = 0, WO_OUT = 6 * MiB, WO_1 = 8 * MiB, WO_2 = 16 * MiB, WO_G = 24 * MiB, WO_P = 26 * MiB;

struct Args { const float* in[20]; float* out; unsigned char* ws; int ph_lo, ph_hi; };

DI unsigned pk_bf16(float lo, float hi) { typedef float f2 __attribute__((ext_vector_type(2))); typedef __bf16 b2 __attribute__((ext_vector_type(2))); f2 v = {lo, hi}; b2 b = __builtin_convertvector(v, b2); return __builtin_bit_cast(unsigned, b); }
DI float bf_lo(unsigned w) { return __uint_as_float(w << 16); }
DI float bf_hi(unsigned w) { return __uint_as_float(w & 0xffff0000u); }
DI float xhalf(float v) { return __shfl_xor(v, 32); }
DI int crow(int i, int hi) { return (i & 3) + 8 * (i >> 2) + 4 * hi; }
DI f32x16 mfma32(bf16x8 a, bf16x8 b, f32x16 c) { return __builtin_amdgcn_mfma_f32_32x32x16_bf16(a, b, c, 0, 0, 0); }
DI s16x4 tr_read(LAS unsigned char* p) { return __builtin_bit_cast(s16x4, __builtin_amdgcn_ds_read_tr16_b64_v4i16((LAS v4i16_t*)p)); }
DI bf16x8 vfrag(LAS unsigned char* p) { const s16x4 lo = tr_read(p), hi = tr_read(p + 512); return __builtin_shufflevector(lo, hi, 0, 1, 2, 3, 4, 5, 6, 7); }
DI float fexp2(float x) { return __builtin_amdgcn_exp2f(x); }
template <int S> DI bf16x8 packP(const f32x16& p) {
    u32x4 w; w.x = pk_bf16(p[8 * S + 0], p[8 * S + 1]); w.y = pk_bf16(p[8 * S + 2], p[8 * S + 3]); w.z = pk_bf16(p[8 * S + 4], p[8 * S + 5]); w.w = pk_bf16(p[8 * S + 6], p[8 * S + 7]);
    return __builtin_bit_cast(bf16x8, w);
}
DI float wave_sum(float v) {
#pragma unroll
    for (int o = 1; o < 64; o <<= 1) v += __shfl_xor(v, o);
    return v;
}
template <int NO> DI void softmax_step(f32x16& s, float& m, float& l, f32x16 (&o)[NO]) {
    float mx = s[0];
#pragma unroll
    for (int i = 1; i < 16; ++i) mx = fmaxf(mx, s[i]);
    mx = fmaxf(mx, xhalf(mx));
    const float mn = fmaxf(m, mx);
    if (__any(mn > m)) {
        const float al = fexp2(m - mn); l *= al;
#pragma unroll
        for (int t = 0; t < NO; ++t)
#pragma unroll
            for (int i = 0; i < 16; ++i) o[t][i] *= al;
    }
    m = mn;
    float sum = 0.f;
#pragma unroll
    for (int i = 0; i < 16; ++i) { s[i] = fexp2(s[i] - mn); sum += s[i]; }
    l += sum;
}

struct EpiBf16R {
    static constexpr bool PERM = true, AFTER_DRAIN = false;
    bf16_t* O; int ldc; int act; int rope_lo, rope_hi; const float* rope; const float* part;
    DI void operator()(const f32x4 (&acc)[2][2][4][2], const pg8::Unit& u, int wr, int wc, int fr, int fq) const {
        const int row0 = u.pm * 256 + wr * 64 + fr, col0 = u.pn * 256 + wc * 32 + 8 * fq;
        const bool do_rope = (u.pn >= rope_lo) && (u.pn < rope_hi);
        const bool mine = ((wc & 1) == 0) && (fq < 2);
        const float sgn = (fq == 0) ? -1.f : 1.f;
#pragma unroll
        for (int ai = 0; ai < 2; ++ai)
#pragma unroll
            for (int m = 0; m < 4; ++m) {
                const int row = row0 + ai * 128 + m * 16;
                bf16_t* rowp = O + (size_t)row * ldc + col0;
                float rs = 1.f;
                if (part) { const f32x4* pq = (const f32x4*)(part + (size_t)row * 16); const f32x4 t4 = (pq[0] + pq[1]) + (pq[2] + pq[3]); rs = 1.0f / sqrtf(((t4.x + t4.y) + (t4.z + t4.w)) * (1.f / DM) + NORM_EPS); }
                f32x4 c0 = {1.f, 1.f, 1.f, 1.f}, c1 = c0, s0 = {0.f, 0.f, 0.f, 0.f}, s1 = s0;
                if (do_rope && mine) { const float* cs = rope + (size_t)row * 16; c0 = *(const f32x4*)cs; c1 = *(const f32x4*)(cs + 4); s0 = *(const f32x4*)(cs + 8) * sgn; s1 = *(const f32x4*)(cs + 12) * sgn; }
#pragma unroll
                for (int bj = 0; bj < 2; ++bj) {
                    f32x4 v0 = acc[ai][bj][m][0] * rs, v1 = acc[ai][bj][m][1] * rs;
                    if (act == 2) {
#pragma unroll
                        for (int k = 0; k < 4; ++k) { const float a = fmaxf(v0[k], 0.f), b = fmaxf(v1[k], 0.f); v0[k] = a * a; v1[k] = b * b; }
                    }
                    if (do_rope) {
                        f32x4 p0, p1;
#pragma unroll
                        for (int k = 0; k < 4; ++k) { p0[k] = __shfl_xor(v0[k], 16); p1[k] = __shfl_xor(v1[k], 16); }
                        v0 = v0 * c0 + p0 * s0; v1 = v1 * c1 + p1 * s1;
                    }
                    u32x4 w; w.x = pk_bf16(v0[0], v0[1]); w.y = pk_bf16(v0[2], v0[3]); w.z = pk_bf16(v1[0], v1[1]); w.w = pk_bf16(v1[2], v1[3]);
                    *(u32x4*)(rowp + bj * 128) = w;
                }
            }
    }
};
template <bool BASE_BF16> struct EpiRes {
    static constexpr bool PERM = true, AFTER_DRAIN = false;
    const void* base; bf16_t* hb; float* part; int ldc;
    DI void operator()(const f32x4 (&acc)[2][2][4][2], const pg8::Unit& u, int wr, int wc, int fr, int fq) const {
        const int row0 = u.pm * 256 + wr * 64 + fr, col0 = u.pn * 256 + wc * 32 + 8 * fq;
#pragma unroll
        for (int ai = 0; ai < 2; ++ai)
#pragma unroll
            for (int m = 0; m < 4; ++m) {
                const int row = row0 + ai * 128 + m * 16;
                const size_t off = (size_t)row * ldc + col0;
                float ss = 0.f;
#pragma unroll
                for (int bj = 0; bj < 2; ++bj) {
                    const size_t o2 = off + bj * 128;
                    f32x4 b0, b1v;
                    if (BASE_BF16) { const u32x4 bw = *(const u32x4*)((const bf16_t*)base + o2); b0 = (f32x4){bf_lo(bw.x), bf_hi(bw.x), bf_lo(bw.y), bf_hi(bw.y)}; b1v = (f32x4){bf_lo(bw.z), bf_hi(bw.z), bf_lo(bw.w), bf_hi(bw.w)}; }
                    else { b0 = *(const f32x4*)((const float*)base + o2); b1v = *(const f32x4*)((const float*)base + o2 + 4); }
                    const f32x4 r0 = b0 + acc[ai][bj][m][0], r1 = b1v + acc[ai][bj][m][1];
                    u32x4 w; w.x = pk_bf16(r0[0], r0[1]); w.y = pk_bf16(r0[2], r0[3]); w.z = pk_bf16(r1[0], r1[1]); w.w = pk_bf16(r1[2], r1[3]);
                    *(u32x4*)(hb + o2) = w;
                    ss += ((r0[0] * r0[0] + r0[1] * r0[1]) + (r0[2] * r0[2] + r0[3] * r0[3])) + ((r1[0] * r1[0] + r1[1] * r1[1]) + (r1[2] * r1[2] + r1[3] * r1[3]));
                }
                ss += __shfl_xor(ss, 16); ss += __shfl_xor(ss, 32);
                if (fq == 0) part[(size_t)row * 16 + u.pn * 4 + wc] = ss;
            }
    }
};
struct EpiPle {
    static constexpr bool PERM = true, AFTER_DRAIN = false;
    const bf16_t* base; const bf16_t* pp; const float* partin; bf16_t* hb; float* part; int ldc;
    DI void operator()(const f32x4 (&acc)[2][2][4][2], const pg8::Unit& u, int wr, int wc, int fr, int fq) const {
        const int row0 = u.pm * 256 + wr * 64 + fr, col0 = u.pn * 256 + wc * 32 + 8 * fq;
#pragma unroll
        for (int ai = 0; ai < 2; ++ai)
#pragma unroll
            for (int m = 0; m < 4; ++m) {
                const int row = row0 + ai * 128 + m * 16;
                const size_t off = (size_t)row * ldc + col0;
                const f32x4* pq = (const f32x4*)(partin + (size_t)row * 16); const f32x4 t4 = (pq[0] + pq[1]) + (pq[2] + pq[3]);
                const float rs = -1.0f / sqrtf(((t4.x + t4.y) + (t4.z + t4.w)) * (1.f / DM) + NORM_EPS);
                float ss = 0.f;
#pragma unroll
                for (int bj = 0; bj < 2; ++bj) {
                    const size_t o2 = off + bj * 128;
                    const u32x4 pw = *(const u32x4*)(pp + o2), bw = *(const u32x4*)(base + o2);
                    const f32x4 a0 = acc[ai][bj][m][0] * rs, a1 = acc[ai][bj][m][1] * rs;
                    f32x4 r0, r1;
                    r0[0] = bf_lo(bw.x) + bf_lo(pw.x) / (1.f + __expf(a0[0])); r0[1] = bf_hi(bw.x) + bf_hi(pw.x) / (1.f + __expf(a0[1]));
                    r0[2] = bf_lo(bw.y) + bf_lo(pw.y) / (1.f + __expf(a0[2])); r0[3] = bf_hi(bw.y) + bf_hi(pw.y) / (1.f + __expf(a0[3]));
                    r1[0] = bf_lo(bw.z) + bf_lo(pw.z) / (1.f + __expf(a1[0])); r1[1] = bf_hi(bw.z) + bf_hi(pw.z) / (1.f + __expf(a1[1]));
                    r1[2] = bf_lo(bw.w) + bf_lo(pw.w) / (1.f + __expf(a1[2])); r1[3] = bf_hi(bw.w) + bf_hi(pw.w) / (1.f + __expf(a1[3]));
                    u32x4 w; w.x = pk_bf16(r0[0], r0[1]); w.y = pk_bf16(r0[2], r0[3]); w.z = pk_bf16(r1[0], r1[1]); w.w = pk_bf16(r1[2], r1[3]);
                    *(u32x4*)(hb + o2) = w;
                    ss += ((r0[0] * r0[0] + r0[1] * r0[1]) + (r0[2] * r0[2] + r0[3] * r0[3])) + ((r1[0] * r1[0] + r1[1] * r1[1]) + (r1[2] * r1[2] + r1[3] * r1[3]));
                }
                ss += __shfl_xor(ss, 16); ss += __shfl_xor(ss, 32);
                if (fq == 0) part[(size_t)row * 16 + u.pn * 4 + wc] = ss;
            }
    }
};

DI void final_row(const bf16_t* hrow, const float* prow, const float* g, float* orow, int lane) {
    const float pv = (lane < 16) ? prow[lane] : 0.f;
    u32x2 w[4];
#pragma unroll
    for (int j = 0; j < 4; ++j) w[j] = *(const u32x2*)(hrow + 256 * j + lane * 4);
    const float r = 1.0f / sqrtf(wave_sum(pv) * (1.f / DM) + NORM_EPS);
#pragma unroll
    for (int j = 0; j < 4; ++j) {
        const int c0 = 256 * j + lane * 4;
        const f32x4 g0 = *(const f32x4*)(g + c0);
        *(f32x4*)(orow + c0) = (f32x4){bf_lo(w[j].x) * r * g0.x, bf_hi(w[j].x) * r * g0.y, bf_lo(w[j].y) * r * g0.z, bf_hi(w[j].y) * r * g0.w};
    }
}
DI void transpose_item(const float* W, const float* g, int K, int N, bf16_t* WT, float* scr, int item, int lane) {
    const int nblk = N / 64, kb = item / nblk, nb = item % nblk, k0 = 64 * kb, n0 = 64 * nb;
    const int lr = lane >> 4, lc = (lane & 15) * 4;
#pragma unroll 8
    for (int i = 0; i < 16; ++i) {
        const int kk = 4 * i + lr; const float gv = g ? g[k0 + kk] : 1.f;
        const f32x4 v = *(const f32x4*)(W + (size_t)(k0 + kk) * N + n0 + lc);
        float* d = scr + kk * 65 + lc; d[0] = v.x * gv; d[1] = v.y * gv; d[2] = v.z * gv; d[3] = v.w * gv;
    }
    asm volatile("s_waitcnt lgkmcnt(0)" ::: "memory");
    const int c = lane & 7;
#pragma unroll
    for (int j = 0; j < 8; ++j) {
        const int n = (lane >> 3) + 8 * j; const float* s = scr + (8 * c) * 65 + n;
        u32x4 o; o.x = pk_bf16(s[0 * 65], s[1 * 65]); o.y = pk_bf16(s[2 * 65], s[3 * 65]); o.z = pk_bf16(s[4 * 65], s[5 * 65]); o.w = pk_bf16(s[6 * 65], s[7 * 65]);
        *(u32x4*)(WT + (size_t)(n0 + n) * K + k0 + 8 * c) = o;
    }
    asm volatile("s_waitcnt lgkmcnt(0)" ::: "memory");
}
#define GAS __attribute__((address_space(1)))
#define RLX_AGENT __ATOMIC_RELAXED, __HIP_MEMORY_SCOPE_AGENT
#define XB_TMO      128
#define XB_XCNT(j)  (256  + 64 * (j))
#define XB_XSUB(j)  (1280 + 64 * (j))
#define XB_XGEN(j)  (2304 + 64 * (j))
#define XB_TOP      3328
#define XB_TOPGEN   3392
#define XCD_BAR_WORDS 3456
#define XB_SPIN_CAP (1u << 18)

__device__ __forceinline__ unsigned xb_ld(unsigned* p)              { return __hip_atomic_load(p, __ATOMIC_RELAXED, __HIP_MEMORY_SCOPE_AGENT); }
__device__ __forceinline__ unsigned xb_add(unsigned* p, unsigned v) { return __hip_atomic_fetch_add(p, v, __ATOMIC_RELAXED, __HIP_MEMORY_SCOPE_AGENT); }
__device__ __forceinline__ unsigned xb_xcc_id() { return (unsigned)__builtin_amdgcn_s_getreg((3 << 11) | 20) & 0xFu; }
#define XB_SPIN(cond, bar) do { unsigned _sp = 0; while (cond) { __builtin_amdgcn_s_sleep(1); \
    if ((++_sp & 255u) == 0u) { if (xb_ld(&(bar)[XB_TMO])) break; if (_sp > XB_SPIN_CAP) { atomicAdd(&(bar)[XB_TMO], 1u); break; } } } } while (0)

struct XcdBarrier {
    unsigned* bar; unsigned x;
    volatile LAS unsigned* st;
};

__device__ __forceinline__ XcdBarrier xcd_barrier_post(unsigned* bar, volatile LAS unsigned* st) {
    XcdBarrier b; b.bar = bar; b.x = xb_xcc_id(); b.st = st;
    if (threadIdx.x == 0) (void)xb_add(&bar[XB_XCNT(b.x)], 1u);
    return b;
}
__device__ __forceinline__ void xcd_barrier_complete(unsigned* bar, unsigned x, unsigned& nloc, unsigned& nx) {
    const unsigned G = gridDim.x * gridDim.y * gridDim.z;
    unsigned sum, cnt, mine, sp = 0u;
    for (;;) {
        sum = 0u; cnt = 0u; mine = 0u;
#pragma unroll
        for (unsigned j = 0; j < 16; ++j) { const unsigned c = xb_ld(&bar[XB_XCNT(j)]); sum += c; cnt += (c > 0u) ? 1u : 0u; mine = (j == x) ? c : mine; }
        if (sum == G) break;
        __builtin_amdgcn_s_sleep(1);
        if ((++sp & 255u) == 0u) { if (xb_ld(&bar[XB_TMO])) break; if (sp > XB_SPIN_CAP) { atomicAdd(&bar[XB_TMO], 1u); break; } }
    }
    nloc = mine > 0u ? mine : 1u; nx = cnt > 0u ? cnt : 1u;
}

__device__ __forceinline__ void xcd_barrier(const XcdBarrier& b) {
    asm volatile("s_waitcnt vmcnt(0)" ::: "memory");
    __syncthreads();
    if (threadIdx.x == 0) {
        unsigned* bar = b.bar;
        __builtin_amdgcn_s_waitcnt(0);
        unsigned nloc = b.st[0], nx = b.st[1];
        if (nloc == 0u) { xcd_barrier_complete(bar, b.x, nloc, nx); b.st[0] = nloc; b.st[1] = nx; }
        const unsigned old = xb_add(&bar[XB_XSUB(b.x)], 1u);
        const unsigned gen = old / nloc;
        if (old + 1u == (gen + 1u) * nloc) {
            __builtin_amdgcn_fence(__ATOMIC_RELEASE, "agent");
            asm volatile("s_waitcnt vmcnt(0)" ::: "memory");
            const unsigned og = xb_add(&bar[XB_TOP], 1u);
            const unsigned tg = og / nx;
            if (og + 1u == (tg + 1u) * nx) xb_add(&bar[XB_TOPGEN], 1u);
            else XB_SPIN(xb_ld(&bar[XB_TOPGEN]) == tg, bar);
            __builtin_amdgcn_fence(__ATOMIC_ACQUIRE, "agent");
            xb_add(&bar[XB_XGEN(b.x)], 1u);
            asm volatile("s_waitcnt vmcnt(0)" ::: "memory");
        } else {
            XB_SPIN(xb_ld(&bar[XB_XGEN(b.x)]) == gen, bar);
            __builtin_amdgcn_fence(__ATOMIC_ACQUIRE, "agent");
            asm volatile("s_waitcnt vmcnt(0)" ::: "memory");
        }
    }
    __syncthreads();
}

DI void sb_unit(const bf16_t* QKV, bf16_t* ATT, LAS unsigned char* lds3, int b, int head, int qb, int wid, int lane) {
    const int r32 = lane & 31, hi = lane >> 5;
    const size_t rowbase = (size_t)b * SEQ;
    const int q0 = qb * 256 + wid * 32;
    const int qcol = head * 64, kcol = 512 + head * 64, vcol = 1024 + head * 64;
    bf16x8 qf[4];
#pragma unroll
    for (int c = 0; c < 4; ++c) qf[c] = *(const bf16x8*)(QKV + (rowbase + q0 + r32) * QKVW + qcol + 16 * c + 8 * hi);
    f32x16 o[2];
#pragma unroll
    for (int i = 0; i < 16; ++i) { o[0][i] = 0.f; o[1][i] = 0.f; }
    float carry = 0.f;
    LAS unsigned char* vimg = lds3 + wid * 4096;
    LAS unsigned char* vrd = vimg + (4 * hi + ((lane & 15) >> 2)) * 64 + ((lane >> 4) & 1) * 32 + (lane & 3) * 8;
    bf16x8 kf[4]; u32x4 vv[4];
#define SB_LOAD(K0) do { _Pragma("unroll") for (int c = 0; c < 4; ++c) kf[c] = *(const bf16x8*)(QKV + (rowbase + (K0) + r32) * QKVW + kcol + 16 * c + 8 * hi); \
        _Pragma("unroll") for (int i = 0; i < 4; ++i) { const int id = lane + 64 * i, key = id >> 3, ch = id & 7; vv[i] = *(const u32x4*)(QKV + (rowbase + (K0) + key) * QKVW + vcol + ch * 8); } } while (0)
    SB_LOAD(q0);
    for (int k0 = q0; k0 >= 0; k0 -= 32) {
        const bf16x8 kc0 = kf[0], kc1 = kf[1], kc2 = kf[2], kc3 = kf[3];
#pragma unroll
        for (int i = 0; i < 4; ++i) { const int id = lane + 64 * i, key = id >> 3, ch = id & 7; *(LAS u32x4*)(vimg + (ch >> 2) * 2048 + key * 64 + (ch & 3) * 16) = vv[i]; }
        if (k0 >= 32) SB_LOAD(k0 - 32);
        f32x16 s;
#pragma unroll
        for (int i = 0; i < 16; ++i) s[i] = 0.f;
        s = mfma32(kc0, qf[0], s); s = mfma32(kc1, qf[1], s); s = mfma32(kc2, qf[2], s); s = mfma32(kc3, qf[3], s);
        const int qpos = q0 + r32;
        float lk[16];
#pragma unroll
        for (int i = 0; i < 16; ++i) {
            const float z = s[i] * 0.125f;
            const bool past = (k0 + crow(i, hi)) < qpos;
            const float sp = fmaxf(z, 0.f) + __logf(1.f + __expf(-fabsf(z)));
            lk[i] = past ? -sp : 0.f;
            s[i] = past ? z : -INFINITY;
        }
        float gs[4], go[4];
#pragma unroll
        for (int g = 0; g < 4; ++g) { gs[g] = (lk[4 * g] + lk[4 * g + 1]) + (lk[4 * g + 2] + lk[4 * g + 3]); go[g] = xhalf(gs[g]); }
        const float ps0 = gs[0] + go[0], ps1 = gs[1] + go[1], ps2 = gs[2] + go[2], ps3 = gs[3] + go[3];
        float ap[4]; ap[3] = 0.f; ap[2] = ps3; ap[1] = ps3 + ps2; ap[0] = ps3 + ps2 + ps1;
#pragma unroll
        for (int g = 0; g < 4; ++g) {
            const float aft = carry + ap[g] + (hi == 0 ? go[g] : 0.f);
            const float w3 = aft, w2 = aft + lk[4 * g + 3], w1 = w2 + lk[4 * g + 2], w0 = w1 + lk[4 * g + 1];
            s[4 * g + 3] = __expf(s[4 * g + 3] + lk[4 * g + 3] + w3);
            s[4 * g + 2] = __expf(s[4 * g + 2] + lk[4 * g + 2] + w2);
            s[4 * g + 1] = __expf(s[4 * g + 1] + lk[4 * g + 1] + w1);
            s[4 * g + 0] = __expf(s[4 * g + 0] + lk[4 * g + 0] + w0);
        }
        carry += (ps0 + ps1) + (ps2 + ps3);
        const bf16x8 p0 = packP<0>(s), p1 = packP<1>(s);
        asm volatile("s_waitcnt lgkmcnt(0)" ::: "memory");
#pragma unroll
        for (int dt = 0; dt < 2; ++dt) {
            const bf16x8 v0 = vfrag(vrd + dt * 2048), v1 = vfrag(vrd + dt * 2048 + 1024);
            o[dt] = mfma32(v0, p0, o[dt]); o[dt] = mfma32(v1, p1, o[dt]);
        }
        asm volatile("s_waitcnt lgkmcnt(0)" ::: "memory");
        if (__all(carry < -104.f)) break;
    }
#undef SB_LOAD
    bf16_t* op = ATT + (rowbase + q0 + r32) * DM + head * 64;
#pragma unroll
    for (int dt = 0; dt < 2; ++dt)
#pragma unroll
        for (int g = 0; g < 4; ++g) { u32x2 w; w.x = pk_bf16(o[dt][4 * g], o[dt][4 * g + 1]); w.y = pk_bf16(o[dt][4 * g + 2], o[dt][4 * g + 3]); *(u32x2*)(op + 32 * dt + 8 * g + 4 * hi) = w; }
}

constexpr int DF_STAGE = 32768, DF_K2 = 8192, DF_V = 16384;
DI void glds16s(const void* sbase, unsigned voff, unsigned lds_dst) { unsigned keep;
    asm volatile("s_mov_b32 %0, m0\n\ts_mov_b32 m0, %3\n\ts_nop 0\n\tglobal_load_lds_dwordx4 %1, %2\n\ts_mov_b32 m0, %0" : "=&s"(keep) : "v"(voff), "s"(sbase), "s"(lds_dst) : "memory"); }
#define DF_VLD(VF, VOFF, H) do { _Pragma("unroll") for (int d2 = 0; d2 < 2; ++d2) { LAS unsigned char* vb_ = lds3 + (VOFF) + (2 * (H) + d2) * 4096; VF[2 * d2] = vfrag(vb_); VF[2 * d2 + 1] = vfrag(vb_ + 1024); } } while (0)
#define DF_PVM(VF, P0, P1, H) do { _Pragma("unroll") for (int d2 = 0; d2 < 2; ++d2) { o[2 * (H) + d2] = mfma32(VF[2 * d2], P0, o[2 * (H) + d2]); o[2 * (H) + d2] = mfma32(VF[2 * d2 + 1], P1, o[2 * (H) + d2]); } } while (0)
DI void diff_stage(const unsigned char* lds, LAS unsigned char* lds3, int buf, int t, int comp, int q0, int r32, int hi, int vlane, bool skew,
                   const bf16x8 (&qf)[4], f32x16 (&o)[4], float& m, float& l, bf16x8 (&pp)[4], int& pvo, bool& have_prev) {
    const int k0 = 64 * t;
    if (k0 > q0 + 31) return;
    const unsigned char* sb = lds + buf * DF_STAGE + comp * DF_K2 + r32 * 128; const int ke16 = (hi ^ ((r32 >> 1) & 7)) * 16;
    bf16x8 vf[4];
    if (skew && have_prev) {
#pragma unroll
        for (int sub = 0; sub < 2; ++sub) { DF_VLD(vf, pvo + sub * 2048, 0); DF_PVM(vf, pp[2 * sub], pp[2 * sub + 1], 0); DF_VLD(vf, pvo + sub * 2048, 1); DF_PVM(vf, pp[2 * sub], pp[2 * sub + 1], 1); }
    }
    f32x16 s0, s1;
#pragma unroll
    for (int i = 0; i < 16; ++i) { s0[i] = 0.f; s1[i] = 0.f; }
    {
        bf16x8 k0f[4], k1f[4];
#pragma unroll
        for (int c = 0; c < 4; ++c) { k0f[c] = *(const bf16x8*)(sb + ((32 * c) ^ ke16)); k1f[c] = *(const bf16x8*)(sb + 32 * 128 + ((32 * c) ^ ke16)); }
#pragma unroll
        for (int c = 0; c < 4; ++c) { s0 = mfma32(k0f[c], qf[c], s0); s1 = mfma32(k1f[c], qf[c], s1); }
    }
    if (k0 + 63 > q0) {
        const int dq = q0 + r32 - k0 - 4 * hi;
#pragma unroll
        for (int i = 0; i < 16; ++i) { const int ci = (i & 3) + 8 * (i >> 2); s0[i] = (ci > dq) ? -INFINITY : s0[i]; s1[i] = (ci + 32 > dq) ? -INFINITY : s1[i]; }
    }
    float mx = fmaxf(fmaxf(s0[0], s0[1]), s1[0]);
#pragma unroll
    for (int i = 1; i < 15; i += 2) { mx = fmaxf(fmaxf(mx, s0[i + 1]), s0[i + 2 > 15 ? 15 : i + 2]); mx = fmaxf(fmaxf(mx, s1[i]), s1[i + 1]); }
    mx = fmaxf(mx, s1[15]);
    mx = fmaxf(mx, xhalf(mx)) * SCL2;
    if (__any(mx > m + 8.f)) {
        const float mn = fmaxf(m, mx), al = fexp2(m - mn); l *= al; m = mn;
#pragma unroll
        for (int dt = 0; dt < 4; ++dt)
#pragma unroll
            for (int i = 0; i < 16; ++i) o[dt][i] *= al;
    }
    float sum0 = 0.f, sum1 = 0.f;
#pragma unroll
    for (int i = 0; i < 16; ++i) { s0[i] = fexp2(__builtin_fmaf(s0[i], SCL2, -m)); sum0 += s0[i]; s1[i] = fexp2(__builtin_fmaf(s1[i], SCL2, -m)); sum1 += s1[i]; }
    l += sum0 + sum1;
    const int vo = buf * DF_STAGE + DF_V + vlane;
    if (!skew) {
        const bf16x8 p00 = packP<0>(s0), p01 = packP<1>(s0);
        DF_VLD(vf, vo, 0); DF_PVM(vf, p00, p01, 0); DF_VLD(vf, vo, 1); DF_PVM(vf, p00, p01, 1);
        const bf16x8 p10 = packP<0>(s1), p11 = packP<1>(s1);
        DF_VLD(vf, vo + 2048, 0); DF_PVM(vf, p10, p11, 0); DF_VLD(vf, vo + 2048, 1); DF_PVM(vf, p10, p11, 1);
    } else { pp[0] = packP<0>(s0); pp[1] = packP<1>(s0); pp[2] = packP<0>(s1); pp[3] = packP<1>(s1); pvo = vo; have_prev = true; }
}
DI void diff_unit(const Args& A, const bf16_t* QKV, bf16_t* ATT, unsigned char* lds, LAS unsigned char* lds3, int b, int head, int qb, int tid, int wid, int lane) {
    const int r32 = lane & 31, hi = lane >> 5, comp = wid >> 2, wq = wid & 3;
    const size_t rowbase = (size_t)b * SEQ;
    const int q0 = qb * 128 + wq * 32;
    const int qcol = 1536 + head * 128 + comp * 64;
    bf16x8 qf[4];
#pragma unroll
    for (int c = 0; c < 4; ++c) qf[c] = *(const bf16x8*)(QKV + (rowbase + q0 + r32) * QKVW + qcol + 16 * c + 8 * hi);
    f32x16 o[4];
#pragma unroll
    for (int t = 0; t < 4; ++t)
#pragma unroll
        for (int i = 0; i < 16; ++i) o[t][i] = 0.f;
    float m = -INFINITY, l = 0.f;
    const int nst = 2 * (qb + 1);
    const unsigned ldsb = (unsigned)(uintptr_t)lds3;
    const int kkey = 8 * wid + (lane >> 3), kch = (lane & 7) ^ ((kkey >> 1) & 7);
    const int vi0 = 2 * wid, vi1 = 2 * wid + 1;
    const bf16_t* sbase = QKV + rowbase * QKVW + head * 128;
    const unsigned oK = (unsigned)((kkey * QKVW + 2048 + kch * 8) * 2);
    const unsigned oV0 = (unsigned)(((16 * (vi0 & 3) + (lane >> 2)) * QKVW + 2560 + ((vi0 >> 2) * 4 + (lane & 3)) * 8) * 2);
    const unsigned oV1 = (unsigned)(((16 * (vi1 & 3) + (lane >> 2)) * QKVW + 2560 + ((vi1 >> 2) * 4 + (lane & 3)) * 8) * 2);
    const unsigned dK = (unsigned)__builtin_amdgcn_readfirstlane(wid * 1024);
    const unsigned dV0 = (unsigned)__builtin_amdgcn_readfirstlane(DF_V + (vi0 >> 2) * 4096 + (vi0 & 3) * 1024), dV1 = (unsigned)__builtin_amdgcn_readfirstlane(DF_V + (vi1 >> 2) * 4096 + (vi1 & 3) * 1024);
#define DF_DMA(t, bufi) do { const bf16_t* sb_ = sbase + (size_t)(64 * (t)) * QKVW; const unsigned base_ = (unsigned)__builtin_amdgcn_readfirstlane(ldsb + (bufi) * DF_STAGE); \
        glds16s(sb_, oK, base_ + dK); glds16s(sb_, oK + 128u, base_ + DF_K2 + dK); glds16s(sb_, oV0, base_ + dV0); glds16s(sb_, oV1, base_ + dV1); } while (0)
#define DF_WAITBAR(N) asm volatile("s_waitcnt vmcnt(" #N ") lgkmcnt(0)\n\ts_barrier" ::: "memory")
    DF_DMA(0, 0); DF_DMA(1, 1);
    asm volatile("" : "+v"(qf[0]), "+v"(qf[1]), "+v"(qf[2]), "+v"(qf[3]));
    DF_WAITBAR(4);
    const int vlane = (4 * hi + ((lane & 15) >> 2)) * 64 + ((lane >> 4) & 1) * 32 + (lane & 3) * 8;
    const bool skew = false;
    bf16x8 pp[4]; { const bf16x8 z8 = {0, 0, 0, 0, 0, 0, 0, 0}; pp[0] = z8; pp[1] = z8; pp[2] = z8; pp[3] = z8; } int pvo = vlane; bool have_prev = false;
    for (int t = 0; t < nst; ++t) {
        { const int tl = (t + 2 < nst) ? t + 2 : nst - 1; DF_DMA(tl, (t + 2) & 3); }
        diff_stage(lds, lds3, t & 3, t, comp, q0, r32, hi, vlane, skew, qf, o, m, l, pp, pvo, have_prev);
        DF_WAITBAR(4);
    }
    asm volatile("s_waitcnt vmcnt(0)" ::: "memory");
#undef DF_DMA
#undef DF_WAITBAR
    if (skew && have_prev) { bf16x8 vf[4];
#pragma unroll
        for (int sub = 0; sub < 2; ++sub) { DF_VLD(vf, pvo + sub * 2048, 0); DF_PVM(vf, pp[2 * sub], pp[2 * sub + 1], 0); DF_VLD(vf, pvo + sub * 2048, 1); DF_PVM(vf, pp[2 * sub], pp[2 * sub + 1], 1); } }
    __syncthreads();
    float lam;
    {
        const float* lq1 = A.in[6] + head * 64; const float* lk1 = A.in[7] + head * 64; const float* lq2 = A.in[8] + head * 64; const float* lk2 = A.in[9] + head * 64;
        const float d1 = wave_sum(lq1[lane] * lk1[lane]), d2 = wave_sum(lq2[lane] * lk2[lane]);
        lam = __expf(d1) - __expf(d2) + 0.2f;
    }
    const float inv = 1.f / (l + xhalf(l));
    float* X = (float*)lds;
    if (comp == 1) {
#pragma unroll
        for (int t = 0; t < 4; ++t)
#pragma unroll
            for (int i = 0; i < 16; ++i) X[(wq * 64 + t * 16 + i) * 64 + lane] = o[t][i] * inv;
    }
    __syncthreads();
    if (comp == 0) {
        float ss = 0.f;
#pragma unroll
        for (int t = 0; t < 4; ++t)
#pragma unroll
            for (int i = 0; i < 16; ++i) { const float v = o[t][i] * inv - lam * X[(wq * 64 + t * 16 + i) * 64 + lane]; o[t][i] = v; ss += v * v; }
        ss += xhalf(ss);
        const float r = 0.8f / sqrtf(ss * (1.f / 128.f) + NORM_EPS);
        const float* g = A.in[10];
        bf16_t* op = ATT + (rowbase + q0 + r32) * DM + 512 + head * 128;
#pragma unroll
        for (int t = 0; t < 4; ++t)
#pragma unroll
            for (int gq = 0; gq < 4; ++gq) {
                const int d = 32 * t + 8 * gq + 4 * hi; const f32x4 gg = *(const f32x4*)(g + d);
                u32x2 w; w.x = pk_bf16(o[t][4 * gq] * r * gg.x, o[t][4 * gq + 1] * r * gg.y); w.y = pk_bf16(o[t][4 * gq + 2] * r * gg.z, o[t][4 * gq + 3] * r * gg.w);
                *(u32x2*)(op + d) = w;
            }
    }
    __syncthreads();
}
#undef DF_VLD
#undef DF_PVM

DI void phase_attn0(const Args& A, unsigned char* lds, LAS unsigned char* lds3, int tid, int wid, int lane) {
    const bf16_t* QKV = (const bf16_t*)(A.ws + WS_QKV); bf16_t* ATT = (bf16_t*)(A.ws + WS_ATT);
    const int G = gridDim.x;
    for (int pi = blockIdx.x; pi < 512; pi += G) {
        const int pid = (G == 256) ? ((pi & 7) * 64 + ((pi >> 3) & 31) + (pi >> 8) * 32) : pi;
        const int bh = pid >> 6, s = pid & 63, b = bh >> 2, head = bh & 3;
        diff_unit(A, QKV, ATT, lds, lds3, b, head, 127 - s, tid, wid, lane);
        diff_unit(A, QKV, ATT, lds, lds3, b, head, s, tid, wid, lane);
    }
}
DI void phase_attn0_sb(const Args& A, LAS unsigned char* lds3, int wid, int lane) {
    const bf16_t* QKV = (const bf16_t*)(A.ws + WS_QKV); bf16_t* ATT = (bf16_t*)(A.ws + WS_ATT);
    const int G = gridDim.x;
    for (int u = blockIdx.x; u < 1024; u += G) {
        const int bh = u >> 6, qb = u & 63, b = bh >> 3, head = bh & 7;
        sb_unit(QKV, ATT, lds3, b, head, qb, wid, lane);
    }
}


DI void phase_kmean(const Args& A, int gw, int ngw, int lane) {
    const bf16_t* QKV = (const bf16_t*)(A.ws + WS_QKV); float* KM = (float*)(A.ws + WS_KM);
    for (int u = gw; u < BATCH * 16 * 64; u += ngw) {
        const int blk = u & 63, bh = u >> 6, b = bh >> 4, h = bh & 15;
        const int ch = lane & 7, sub = lane >> 3;
        float acc[8];
#pragma unroll
        for (int k = 0; k < 8; ++k) acc[k] = 0.f;
        const bf16_t* base = QKV + ((size_t)b * SEQ + blk * 256 + sub) * QKVW + 1024 + h * 64 + ch * 8;
#pragma unroll 4
        for (int it = 0; it < 32; ++it) {
            const u32x4 w = *(const u32x4*)(base + (size_t)it * 8 * QKVW);
            acc[0] += bf_lo(w.x); acc[1] += bf_hi(w.x); acc[2] += bf_lo(w.y); acc[3] += bf_hi(w.y); acc[4] += bf_lo(w.z); acc[5] += bf_hi(w.z); acc[6] += bf_lo(w.w); acc[7] += bf_hi(w.w);
        }
#pragma unroll
        for (int k = 0; k < 8; ++k) { float v = acc[k]; v += __shfl_xor(v, 8); v += __shfl_xor(v, 16); v += __shfl_xor(v, 32); acc[k] = v * (1.f / 256.f); }
        if (lane < 8) { float* o = KM + (size_t)u * 64 + ch * 8; *(f32x4*)o = (f32x4){acc[0], acc[1], acc[2], acc[3]}; *(f32x4*)(o + 4) = (f32x4){acc[4], acc[5], acc[6], acc[7]}; }
    }
}
DI void top3_insert(float v, int idx, float& v1, int& i1, float& v2, int& i2, float& v3, int& i3) {
    const bool b1 = (v > v1) || (v == v1 && idx < i1), b2 = (v > v2) || (v == v2 && idx < i2), b3 = (v > v3) || (v == v3 && idx < i3);
    const float nv3 = b2 ? v2 : (b3 ? v : v3), nv2 = b1 ? v1 : (b2 ? v : v2), nv1 = b1 ? v : v1;
    const int ni3 = b2 ? i2 : (b3 ? idx : i3), ni2 = b1 ? i1 : (b2 ? idx : i2), ni1 = b1 ? idx : i1;
    v1 = nv1; v2 = nv2; v3 = nv3; i1 = ni1; i2 = ni2; i3 = ni3;
}
DI void phase_gate(const Args& A, int gw, int ngw, int lane) {
    const bf16_t* QKV = (const bf16_t*)(A.ws + WS_QKV); const float* KM = (const float*)(A.ws + WS_KM); unsigned* SEL = (unsigned*)(A.ws + WS_SEL);
    const int r32 = lane & 31, hi = lane >> 5;
    for (int u = gw; u < BATCH * 16 * 512; u += ngw) {
        const int qt = u & 511, bh = u >> 9, b = bh >> 4, h = bh & 15;
        const int own = qt >> 3;
        const size_t srow = (size_t)bh * SEQ + qt * 32 + r32;
        if (own == 0) { if (hi == 0) SEL[srow] = 0xffffffffu; continue; }
        bf16x8 qf[4];
#pragma unroll
        for (int c = 0; c < 4; ++c) qf[c] = *(const bf16x8*)(QKV + ((size_t)b * SEQ + qt * 32 + r32) * QKVW + h * 64 + 16 * c + 8 * hi);
        float v1 = -INFINITY, v2 = -INFINITY, v3 = -INFINITY; int i1 = 255, i2 = 255, i3 = 255;
        const int nmt = (own + 31) >> 5;
        for (int mt = 0; mt < nmt; ++mt) {
            f32x16 acc;
#pragma unroll
            for (int i = 0; i < 16; ++i) acc[i] = 0.f;
#pragma unroll
            for (int c = 0; c < 4; ++c) {
                const float* kp = KM + ((size_t)bh * 64 + 32 * mt + r32) * 64 + 16 * c + 8 * hi;
                const f32x4 x0 = *(const f32x4*)kp, x1 = *(const f32x4*)(kp + 4);
                u32x4 wh, wl;
                wh.x = pk_bf16(x0[0], x0[1]); wh.y = pk_bf16(x0[2], x0[3]); wh.z = pk_bf16(x1[0], x1[1]); wh.w = pk_bf16(x1[2], x1[3]);
                wl.x = pk_bf16(x0[0] - bf_lo(wh.x), x0[1] - bf_hi(wh.x)); wl.y = pk_bf16(x0[2] - bf_lo(wh.y), x0[3] - bf_hi(wh.y));
                wl.z = pk_bf16(x1[0] - bf_lo(wh.z), x1[1] - bf_hi(wh.z)); wl.w = pk_bf16(x1[2] - bf_lo(wh.w), x1[3] - bf_hi(wh.w));
                acc = mfma32(__builtin_bit_cast(bf16x8, wh), qf[c], acc);
                acc = mfma32(__builtin_bit_cast(bf16x8, wl), qf[c], acc);
            }
#pragma unroll
            for (int i = 0; i < 16; ++i) { const int blk = 32 * mt + crow(i, hi); const bool ok = blk < own; top3_insert(ok ? acc[i] : -INFINITY, ok ? blk : 255, v1, i1, v2, i2, v3, i3); }
        }
        const float ov1 = xhalf(v1), ov2 = xhalf(v2), ov3 = xhalf(v3);
        const int oi1 = __shfl_xor(i1, 32), oi2 = __shfl_xor(i2, 32), oi3 = __shfl_xor(i3, 32);
        top3_insert(ov1, oi1, v1, i1, v2, i2, v3, i3);
        top3_insert(ov2, oi2, v1, i1, v2, i2, v3, i3);
        top3_insert(ov3, oi3, v1, i1, v2, i2, v3, i3);
        if (hi == 0) SEL[srow] = (unsigned)i1 | ((unsigned)i2 << 8) | ((unsigned)i3 << 16) | 0xff000000u;
    }
}
constexpr int MB_K = 0, MB_V = 36864, MB_LIST = 69632, MB_MISC = 102400;
DI void moba_tile(const unsigned char* lds, LAS unsigned char* lds3, const bf16x8 (&qf)[4], int nsub, int diag_sub, int lane, f32x16 (&o)[2], float& m, float& l) {
    const int r32 = lane & 31, hi = lane >> 5;
    const int vlane = (4 * hi + ((lane & 15) >> 2)) * 64 + ((lane >> 4) & 1) * 32 + (lane & 3) * 8;
    for (int kk = 0; kk < nsub; ++kk) {
        bf16x8 kf[4], vf[4];
#pragma unroll
        for (int c = 0; c < 4; ++c) kf[c] = *(const bf16x8*)(lds + MB_K + (32 * kk + r32) * 144 + (16 * c + 8 * hi) * 2);
#pragma unroll
        for (int dt = 0; dt < 2; ++dt) { LAS unsigned char* vb = lds3 + MB_V + dt * 16384 + (32 * kk) * 64 + vlane; vf[2 * dt] = vfrag(vb); vf[2 * dt + 1] = vfrag(vb + 1024); }
        f32x16 s;
#pragma unroll
        for (int i = 0; i < 16; ++i) s[i] = 0.f;
#pragma unroll
        for (int c = 0; c < 4; ++c) s = mfma32(kf[c], qf[c], s);
        if (kk == diag_sub) {
            const int dq = r32 - 4 * hi;
#pragma unroll
            for (int i = 0; i < 16; ++i) s[i] = (((i & 3) + 8 * (i >> 2)) > dq) ? -INFINITY : s[i];
        }
        float mx = fmaxf(fmaxf(s[0], s[1]), s[2]);
#pragma unroll
        for (int i = 3; i < 15; i += 2) mx = fmaxf(fmaxf(mx, s[i]), s[i + 1]);
        mx = fmaxf(mx, s[15]);
        mx = fmaxf(mx, xhalf(mx)) * SCL2;
        const bool trig = mx > m + 8.f;
        if (__any(trig)) {
            const float mn = trig ? mx : m, al = fexp2(m - mn); l *= al; m = mn;
#pragma unroll
            for (int dt = 0; dt < 2; ++dt)
#pragma unroll
                for (int i = 0; i < 16; ++i) o[dt][i] *= al;
        }
        float sum = 0.f;
#pragma unroll
        for (int i = 0; i < 16; ++i) { s[i] = fexp2(__builtin_fmaf(s[i], SCL2, -m)); sum += s[i]; }
        l += sum;
        const bf16x8 p0 = packP<0>(s), p1 = packP<1>(s);
#pragma unroll
        for (int dt = 0; dt < 2; ++dt) { o[dt] = mfma32(vf[2 * dt], p0, o[dt]); o[dt] = mfma32(vf[2 * dt + 1], p1, o[dt]); }
    }
}
DI void moba_stage_kv(const bf16_t* QKV, unsigned char* lds, int b, int h, int blk, int tid) {
    const bf16_t* kb = QKV + ((size_t)b * SEQ + blk * 256) * QKVW + 1024 + h * 64;
    const bf16_t* vb = QKV + ((size_t)b * SEQ + blk * 256) * QKVW + 2048 + h * 64;
    u32x4 kr[4], vr[4];
#pragma unroll
    for (int i = 0; i < 4; ++i) { const int id = tid + 512 * i, key = id >> 3, ch = id & 7; kr[i] = *(const u32x4*)(kb + (size_t)key * QKVW + ch * 8); vr[i] = *(const u32x4*)(vb + (size_t)key * QKVW + ch * 8); }
#pragma unroll
    for (int i = 0; i < 4; ++i) { const int id = tid + 512 * i, key = id >> 3, ch = id & 7; *(u32x4*)(lds + MB_K + key * 144 + ch * 16) = kr[i]; *(u32x4*)(lds + MB_V + (ch >> 2) * 16384 + key * 64 + (ch & 3) * 16) = vr[i]; }
}
DI void phase_moba_sel(const Args& A, unsigned char* lds, LAS unsigned char* lds3, int tid, int wid, int lane) {
    const bf16_t* QKV = (const bf16_t*)(A.ws + WS_QKV); const unsigned* SEL = (const unsigned*)(A.ws + WS_SEL);
    bf16_t* PO = (bf16_t*)(A.ws + WS_PO); float* PML = (float*)(A.ws + WS_PML);
    unsigned* ctr = (unsigned*)(A.ws + WS_CTL) + 64;
    volatile int* misc = (volatile int*)(lds + MB_MISC);
    unsigned short* list = (unsigned short*)(lds + MB_LIST);
    const int r32 = lane & 31, hi = lane >> 5;
    for (;;) {
        __syncthreads();
        if (tid == 0) { misc[0] = (int)atomicAdd(ctr, 1u); misc[1] = 0; }
        __syncthreads();
        const int u = misc[0];
        if (u >= 63 * 32) break;
        const int j = u >> 5, bh = u & 31, b = bh >> 4, h = bh & 15;
        moba_stage_kv(QKV, lds, b, h, j, tid);
        const unsigned* selp = SEL + (size_t)bh * SEQ;
        for (int s0 = (j + 1) * 256 + tid; s0 < SEQ; s0 += 8 * NTHR) {
            unsigned wv[8];
#pragma unroll
            for (int k = 0; k < 8; ++k) { const int s = s0 + k * NTHR; wv[k] = (s < SEQ) ? selp[s] : 0xffffffffu; }
#pragma unroll
            for (int k = 0; k < 8; ++k) {
                const int s = s0 + k * NTHR; const unsigned w = wv[k];
                int slot = -1;
                if ((int)(w & 255u) == j) slot = 0; else if ((int)((w >> 8) & 255u) == j) slot = 1; else if ((int)((w >> 16) & 255u) == j) slot = 2;
                if (slot >= 0) { const int pos = atomicAdd((int*)&misc[1], 1); list[pos] = (unsigned short)((s << 2) | slot); }
            }
        }
        __syncthreads();
        const int cnt = misc[1];
        const int ntile = (cnt + 31) >> 5;
        for (int tl = wid; tl < ntile; tl += NWAVES) {
            const int e = tl * 32 + r32; const bool valid = e < cnt;
            const int ent = list[valid ? e : 0];
            const int s = ent >> 2, slot = ent & 3;
            bf16x8 qf[4];
#pragma unroll
            for (int c = 0; c < 4; ++c) qf[c] = *(const bf16x8*)(QKV + ((size_t)b * SEQ + s) * QKVW + h * 64 + 16 * c + 8 * hi);
            f32x16 o[2];
#pragma unroll
            for (int i = 0; i < 16; ++i) { o[0][i] = 0.f; o[1][i] = 0.f; }
            float m = -INFINITY, l = 0.f;
            moba_tile(lds, lds3, qf, 8, -1, lane, o, m, l);
            const float lt = l + xhalf(l), inv = 1.f / lt;
            if (valid) {
                const size_t pe = ((size_t)bh * SEQ + s) * 3 + slot;
                bf16_t* op = PO + pe * 64;
#pragma unroll
                for (int dt = 0; dt < 2; ++dt)
#pragma unroll
                    for (int gp = 0; gp < 2; ++gp) { u32x4 w; w.x = pk_bf16(o[dt][8 * gp] * inv, o[dt][8 * gp + 1] * inv); w.y = pk_bf16(o[dt][8 * gp + 2] * inv, o[dt][8 * gp + 3] * inv); w.z = pk_bf16(o[dt][8 * gp + 4] * inv, o[dt][8 * gp + 5] * inv); w.w = pk_bf16(o[dt][8 * gp + 6] * inv, o[dt][8 * gp + 7] * inv); *(u32x4*)(op + hi * 32 + dt * 16 + gp * 8) = w; }
                if (hi == 0) { PML[pe * 2] = m; PML[pe * 2 + 1] = lt; }
            }
        }
    }
}
constexpr int MB_GRP = 69632;
DI void moba_stage_kv256(const bf16_t* QKV, unsigned char* ldsg, int b, int h, int blk, int ltid) {
    const bf16_t* kb = QKV + ((size_t)b * SEQ + blk * 256) * QKVW + 1024 + h * 64;
    const bf16_t* vb = QKV + ((size_t)b * SEQ + blk * 256) * QKVW + 2048 + h * 64;
    u32x4 r[8];
#pragma unroll
    for (int i = 0; i < 8; ++i) { const int id = ltid + 256 * i, key = id >> 3, ch = id & 7; r[i] = *(const u32x4*)(kb + (size_t)key * QKVW + ch * 8); }
#pragma unroll
    for (int i = 0; i < 8; ++i) { const int id = ltid + 256 * i, key = id >> 3, ch = id & 7; *(u32x4*)(ldsg + MB_K + key * 144 + ch * 16) = r[i]; }
#pragma unroll
    for (int i = 0; i < 8; ++i) { const int id = ltid + 256 * i, key = id >> 3, ch = id & 7; r[i] = *(const u32x4*)(vb + (size_t)key * QKVW + ch * 8); }
#pragma unroll
    for (int i = 0; i < 8; ++i) { const int id = ltid + 256 * i, key = id >> 3, ch = id & 7; *(u32x4*)(ldsg + MB_V + (ch >> 2) * 16384 + key * 64 + (ch & 3) * 16) = r[i]; }
}
DI void phase_moba_own(const Args& A, unsigned char* lds, LAS unsigned char* lds3, int tid, int wid, int lane) {
    const bf16_t* QKV = (const bf16_t*)(A.ws + WS_QKV); const unsigned* SEL = (const unsigned*)(A.ws + WS_SEL);
    const bf16_t* PO = (const bf16_t*)(A.ws + WS_PO); const float* PML = (const float*)(A.ws + WS_PML); bf16_t* ATT = (bf16_t*)(A.ws + WS_ATT);
    const int r32 = lane & 31, hi = lane >> 5, grp = wid >> 2, g4 = wid & 3;
    unsigned char* ldsg = lds + grp * MB_GRP; LAS unsigned char* lds3g = lds3 + grp * MB_GRP;
    for (int u0 = 2 * blockIdx.x; u0 < BATCH * 16 * 64; u0 += 2 * gridDim.x) {
        const int u = u0 + grp, i = u & 63, bh = u >> 6, b = bh >> 4, h = bh & 15;
        __syncthreads();
        moba_stage_kv256(QKV, ldsg, b, h, i, tid & 255);
        __syncthreads();
#pragma unroll 1
        for (int pass = 0; pass < 2; ++pass) {
            const int tile = pass == 0 ? g4 : 7 - g4;
            const int s = i * 256 + tile * 32 + r32;
            bf16x8 qf[4];
#pragma unroll
            for (int c = 0; c < 4; ++c) qf[c] = *(const bf16x8*)(QKV + ((size_t)b * SEQ + s) * QKVW + h * 64 + 16 * c + 8 * hi);
            f32x16 o[2];
#pragma unroll
            for (int k = 0; k < 16; ++k) { o[0][k] = 0.f; o[1][k] = 0.f; }
            float m = -INFINITY, l = 0.f;
            const unsigned w = SEL[(size_t)bh * SEQ + s];
            const size_t pe0 = ((size_t)bh * SEQ + s) * 3;
            float pm[3], pl[3]; u32x2 pw[3][8];
#pragma unroll
            for (int slot = 0; slot < 3; ++slot) {
                pm[slot] = PML[(pe0 + slot) * 2]; pl[slot] = PML[(pe0 + slot) * 2 + 1];
#pragma unroll
                for (int dt = 0; dt < 2; ++dt)
#pragma unroll
                    for (int gp = 0; gp < 2; ++gp) { const u32x4 q4 = *(const u32x4*)(PO + (pe0 + slot) * 64 + hi * 32 + dt * 16 + gp * 8); pw[slot][dt * 4 + 2 * gp] = (u32x2){q4.x, q4.y}; pw[slot][dt * 4 + 2 * gp + 1] = (u32x2){q4.z, q4.w}; }
            }
            moba_tile(ldsg, lds3g, qf, tile + 1, tile, lane, o, m, l);
            l += xhalf(l);
#pragma unroll
            for (int slot = 0; slot < 3; ++slot) {
                const int idx = (int)((w >> (8 * slot)) & 255u);
                if (idx != 255) {
                    const float mp = pm[slot], lp = pl[slot];
                    const float M = fmaxf(m, mp), a = fexp2(m - M), bq = fexp2(mp - M) * lp;
#pragma unroll
                    for (int dt = 0; dt < 2; ++dt)
#pragma unroll
                        for (int g = 0; g < 4; ++g) {
                            const u32x2 q2 = pw[slot][dt * 4 + g];
                            o[dt][4 * g] = o[dt][4 * g] * a + bf_lo(q2.x) * bq; o[dt][4 * g + 1] = o[dt][4 * g + 1] * a + bf_hi(q2.x) * bq;
                            o[dt][4 * g + 2] = o[dt][4 * g + 2] * a + bf_lo(q2.y) * bq; o[dt][4 * g + 3] = o[dt][4 * g + 3] * a + bf_hi(q2.y) * bq;
                        }
                    l = l * a + bq; m = M;
                }
            }
            const float inv = 1.f / l;
            bf16_t* op = ATT + ((size_t)b * SEQ + s) * DM + h * 64;
#pragma unroll
            for (int dt = 0; dt < 2; ++dt)
#pragma unroll
                for (int g = 0; g < 4; ++g) { u32x2 ww; ww.x = pk_bf16(o[dt][4 * g] * inv, o[dt][4 * g + 1] * inv); ww.y = pk_bf16(o[dt][4 * g + 2] * inv, o[dt][4 * g + 3] * inv); *(u32x2*)(op + 32 * dt + 8 * g + 4 * hi) = ww; }
        }
    }
}


#ifndef MK_MULTI
#define MK_MULTI 0
#endif
constexpr int NPHASE = 17;


__constant__ float ROPE_INV_FREQ[8] = {1.0f, 0.1939227432012558f, 0.03760603070259094f, 0.007292664609849453f, 0.0014142135623842478f, 0.00027424818836152554f, 5.3182957344688475e-05f, 1.0313385246263351e-05f};

template <class Epi, bool ALIGN = true> DI void run_gemm(unsigned char* lds, const bf16_t* Am, const bf16_t* Bt, int N, int K, const Epi& E) {
    pg8::Gemm g{Am, Bt, NT, N, K}; pg8::StaticOrder S; S.init(NT, N, (int)gridDim.x, (int)blockIdx.x);
    pg8::gemm_phase<Epi, pg8::StaticOrder, ALIGN, true>((PG8_LAS unsigned char*)lds, g, S, E);
}

typedef const __attribute__((address_space(4))) Args* KArgsP;
DI const Args* kargs() {
#if defined(__HIP_DEVICE_COMPILE__)
    KArgsP p = (KArgsP)__builtin_amdgcn_kernarg_segment_ptr(); asm volatile("" : "+s"(p)); return (const Args*)p;
#else
    return nullptr;
#endif
}
DI int otid() { int t = threadIdx.x; asm volatile("" : "+v"(t)); return t; }
#define CTX const Args A = *kargs(); const int tid = otid(), lane = tid & 63, wid = __builtin_amdgcn_readfirstlane(tid >> 6); LAS unsigned char* lds3 = (LAS unsigned char*)lds; \
    const int G = gridDim.x, gw = blockIdx.x * NWAVES + wid, ngw = G * NWAVES; unsigned char* ws = A.ws; float* out = A.out; (void)lane; (void)lds3; (void)gw; (void)ngw; (void)ws; (void)out; (void)G;

#define IN(k) (lo <= (k) && (k) < hi_ph)
#if MK_MULTI
#define SEAM(k) do { } while (0)
#else
#define SEAM(k) do { if (IN(k) && IN((k) + 1)) { if ((k) == 0) cg::this_grid().sync(); else { XcdBarrier xb_; xb_.bar = (unsigned*)(kargs()->ws + WS_CTL + CTL_BAR_OFF); xb_.x = xb_xcc_id(); xb_.st = (volatile LAS unsigned*)xb_st; xcd_barrier(xb_); } } } while (0)
#endif
#define WB(l) (ws + ((l) == 0 ? WS_WL0 : WS_WL1))
#define pU ((bf16_t*)(ws + WS_U))
#define pQKV ((bf16_t*)(ws + WS_QKV))
#define pATT ((bf16_t*)(ws + WS_ATT))
#define pHID ((bf16_t*)(ws + WS_HID))
#define pPP ((bf16_t*)(ws + WS_PP))
#define pROPE ((const float*)(ws + WS_ROPE))
#define pHB2 ((bf16_t*)out)
#define pPA ((float*)(ws + WS_PA))
#define pPB ((float*)(ws + WS_PB))
template <int l> DI void layer_phases(unsigned char* lds, unsigned* xb_st, const int lo, const int hi_ph) {
    int ph = (l == 0) ? 1 : 7;

        if (IN(ph)) { CTX EpiBf16R E{pQKV, QKVW, 0, l == 0 ? 6 : 0, l == 0 ? 10 : 8, pROPE, l == 0 ? pPA : pPB}; run_gemm(lds, l == 0 ? pU : pHB2, (const bf16_t*)(WB(l) + WO_IN), QKVW, DM, E); }
        SEAM(ph); ++ph;
        if (l == 0) {
            if (IN(ph)) { { CTX phase_attn0(A, lds, lds3, tid, wid, lane); } { CTX phase_attn0_sb(A, lds3, wid, lane); }
            }
            SEAM(ph); ++ph;
        } else {
            if (IN(ph)) { CTX phase_kmean(A, gw, ngw, lane); }
            SEAM(ph); ++ph;
            if (IN(ph)) { CTX phase_gate(A, gw, ngw, lane); }
            SEAM(ph); ++ph;
            if (IN(ph)) { CTX phase_moba_sel(A, lds, lds3, tid, wid, lane); }
            SEAM(ph); ++ph;
            if (IN(ph)) { CTX phase_moba_own(A, lds, lds3, tid, wid, lane); }
            SEAM(ph); ++ph;
        }
        if (IN(ph)) { CTX __syncthreads(); if (l == 0) { EpiRes<false> E{A.in[0], pU, pPA, DM}; run_gemm(lds, pATT, (const bf16_t*)(WB(l) + WO_OUT), DM, DM, E); } else { EpiRes<true> E{pHB2, pU, pPA, DM}; run_gemm(lds, pATT, (const bf16_t*)(WB(l) + WO_OUT), DM, DM, E); } }
        SEAM(ph); ++ph;
        if (IN(ph)) { CTX EpiBf16R E{pHID, FF, 2, 0, 0, pROPE, pPA}; run_gemm(lds, pU, (const bf16_t*)(WB(l) + WO_1), FF, DM, E); }
        SEAM(ph); ++ph;
        if (IN(ph)) { CTX EpiRes<true> E{pU, pU, pPA, DM}; run_gemm(lds, pHID, (const bf16_t*)(WB(l) + WO_2), DM, FF, E); }
        SEAM(ph); ++ph;
        if (IN(ph)) {
            { CTX EpiBf16R E{pPP, DM, 0, 0, 0, pROPE, nullptr}; run_gemm(lds, (const bf16_t*)(ws + (l == 0 ? WS_PB0 : WS_PB1)), (const bf16_t*)(WB(l) + WO_P), DM, PLE, E); }
            __threadfence(); __syncthreads();
            { CTX EpiPle E{pU, pPP, pPA, l == 0 ? pHB2 : pATT, pPB, DM}; run_gemm(lds, pU, (const bf16_t*)(WB(l) + WO_G), DM, DM, E); }
        }
        SEAM(ph); ++ph;
        if (l == 1) {
            if (IN(ph)) { CTX for (int m = gw; m < NT; m += 2 * ngw) { final_row(pATT + (size_t)m * DM, pPB + (size_t)m * 16, A.in[19], out + (size_t)m * DM, lane); if (m + ngw < NT) final_row(pATT + (size_t)(m + ngw) * DM, pPB + (size_t)(m + ngw) * 16, A.in[19], out + (size_t)(m + ngw) * DM, lane); } }
            ++ph;
        }
    }

__global__ void __launch_bounds__(NTHR, 2) mega_fwd(Args KA) {
    __shared__ __attribute__((aligned(16))) unsigned char lds[139264];
    const int lo = KA.ph_lo, hi_ph = KA.ph_hi;
    __shared__ __attribute__((aligned(16))) unsigned xb_st[4];
#if !MK_MULTI
    if (threadIdx.x < 4) xb_st[threadIdx.x] = 0u;
    __syncthreads();
    (void)xcd_barrier_post((unsigned*)(kargs()->ws + WS_CTL + CTL_BAR_OFF), (volatile LAS unsigned*)xb_st);
#endif
    if (IN(0)) {
        CTX
        float* scr = (float*)(lds + wid * 17408);
#pragma unroll
        for (int l = 0; l < 2; ++l) {
            unsigned char* wb = ws + (l == 0 ? WS_WL0 : WS_WL1);
            const float* srcs[6] = {A.in[l == 0 ? 4 : 11], A.in[l == 0 ? 5 : 12], A.in[14] + (size_t)l * DM * FF, A.in[15] + (size_t)l * FF * DM, A.in[17] + (size_t)l * DM * DM, A.in[18] + (size_t)l * PLE * DM};
            const int Ks[6] = {DM, DM, DM, FF, DM, PLE}, Ns[6] = {QKVW, DM, FF, DM, DM, DM};
            const float* gs[6] = {A.in[3] + l * DM, nullptr, A.in[13] + l * DM, nullptr, A.in[16] + l * DM, nullptr};
            const size_t offs[6] = {WO_IN, WO_OUT, WO_1, WO_2, WO_G, WO_P};
#pragma unroll
            for (int w = 0; w < 6; ++w) {
                const int nitems = (Ks[w] / 64) * (Ns[w] / 64);
                for (int it = gw; it < nitems; it += ngw) transpose_item(srcs[w], gs[w], Ks[w], Ns[w], (bf16_t*)(wb + offs[w]), scr, it, lane);
            }
        }
        {
            float* rope = (float*)(ws + WS_ROPE); const int* pos = (const int*)A.in[2];
            for (int idx = blockIdx.x * NTHR + tid; idx < NT * 8; idx += G * NTHR) {
                const int row = idx >> 3, i = idx & 7;
                const float ang = (float)pos[row] * ROPE_INV_FREQ[i];
                const double rev = (double)ang * 0.15915494309189535; const float fr = (float)(rev - rint(rev));
                rope[(size_t)row * 16 + i] = __builtin_amdgcn_cosf(fr); rope[(size_t)row * 16 + 8 + i] = __builtin_amdgcn_sinf(fr);
            }
        }
        {
            const float* p = A.in[1];
            constexpr int NG = 2 * NT * PLE / 8, HALF = NT * PLE / 8;
            for (int idx0 = blockIdx.x * NTHR + tid; idx0 < NG; idx0 += 4 * G * NTHR) {
                f32x4 a[4], b[4];
#pragma unroll
                for (int k = 0; k < 4; ++k) { const int idx = idx0 + k * G * NTHR; if (idx < NG) { a[k] = *(const f32x4*)(p + (size_t)idx * 8); b[k] = *(const f32x4*)(p + (size_t)idx * 8 + 4); } }
#pragma unroll
                for (int k = 0; k < 4; ++k) { const int idx = idx0 + k * G * NTHR; if (idx < NG) {
                    const int l = idx / HALF, r = idx % HALF;
                    u32x4 w; w.x = pk_bf16(a[k].x, a[k].y); w.y = pk_bf16(a[k].z, a[k].w); w.z = pk_bf16(b[k].x, b[k].y); w.w = pk_bf16(b[k].z, b[k].w);
                    *(u32x4*)((bf16_t*)(ws + (l == 0 ? WS_PB0 : WS_PB1)) + (size_t)r * 8) = w; } }
            }
        }
        {
            const float* x = A.in[0]; bf16_t* hb = (bf16_t*)(ws + WS_U); float* pa = (float*)(ws + WS_PA);
            for (int m = gw; m < NT; m += 2 * ngw) {
                const int m2 = m + ngw;
                const f32x4* xr = (const f32x4*)(x + (size_t)m * DM) + lane; const f32x4* xr2 = (const f32x4*)(x + (size_t)(m2 < NT ? m2 : m) * DM) + lane;
                f32x4 v[4], v2[4];
#pragma unroll
                for (int j = 0; j < 4; ++j) { v[j] = xr[64 * j]; v2[j] = xr2[64 * j]; }
                float s = 0.f, s2 = 0.f;
#pragma unroll
                for (int j = 0; j < 4; ++j) { s += (v[j].x * v[j].x + v[j].y * v[j].y) + (v[j].z * v[j].z + v[j].w * v[j].w); s2 += (v2[j].x * v2[j].x + v2[j].y * v2[j].y) + (v2[j].z * v2[j].z + v2[j].w * v2[j].w); }
                s = wave_sum(s); s2 = wave_sum(s2);
                {
                    u32x2 w[4];
#pragma unroll
                    for (int j = 0; j < 4; ++j) { w[j].x = pk_bf16(v[j].x, v[j].y); w[j].y = pk_bf16(v[j].z, v[j].w); }
                    const bool odd = lane & 1;
#pragma unroll
                    for (int jp = 0; jp < 2; ++jp) {
                        const u32x2 mine = odd ? w[2 * jp + 1] : w[2 * jp], give = odd ? w[2 * jp] : w[2 * jp + 1];
                        u32x2 got; got.x = __shfl_xor(give.x, 1); got.y = __shfl_xor(give.y, 1);
                        const u32x4 st = odd ? (u32x4){got.x, got.y, mine.x, mine.y} : (u32x4){mine.x, mine.y, got.x, got.y};
                        *(u32x4*)(hb + (size_t)m * DM + 256 * (2 * jp + (odd ? 1 : 0)) + (lane & ~1) * 4) = st;
                    }
                }
                if (lane < 16) pa[(size_t)m * 16 + lane] = (lane == 0) ? s : 0.f;
                if (m2 < NT) {
                    u32x2 w[4];
#pragma unroll
                    for (int j = 0; j < 4; ++j) { w[j].x = pk_bf16(v2[j].x, v2[j].y); w[j].y = pk_bf16(v2[j].z, v2[j].w); }
                    const bool odd = lane & 1;
#pragma unroll
                    for (int jp = 0; jp < 2; ++jp) {
                        const u32x2 mine = odd ? w[2 * jp + 1] : w[2 * jp], give = odd ? w[2 * jp] : w[2 * jp + 1];
                        u32x2 got; got.x = __shfl_xor(give.x, 1); got.y = __shfl_xor(give.y, 1);
                        const u32x4 st = odd ? (u32x4){got.x, got.y, mine.x, mine.y} : (u32x4){mine.x, mine.y, got.x, got.y};
                        *(u32x4*)(hb + (size_t)m2 * DM + 256 * (2 * jp + (odd ? 1 : 0)) + (lane & ~1) * 4) = st;
                    }
                    if (lane < 16) pa[(size_t)m2 * 16 + lane] = (lane == 0) ? s2 : 0.f;
                }
            }
        }
    }
    SEAM(0);
    layer_phases<0>(lds, xb_st, lo, hi_ph);
    layer_phases<1>(lds, xb_st, lo, hi_ph);
#undef IN
#undef SEAM
}

extern "C" void kernel_launch(void* const* d_in, const int* in_sizes, int n_in, void* d_out, int out_size, void* d_ws, size_t ws_size, hipStream_t stream) {
    static int grid = 0;
    if (grid == 0) {
        if (n_in != 20 || out_size != NT * DM || ws_size < WS_END) { fprintf(stderr, "kernel_launch: unexpected shapes (n_in %d, out %d, ws %zu < %zu); nothing launched\n", n_in, out_size, ws_size, (size_t)WS_END); grid = -1; return; }
        int dev = 0, cus = 0, per_cu = 0;
        hipGetDevice(&dev);
        hipDeviceGetAttribute(&cus, hipDeviceAttributeMultiprocessorCount, dev);
        hipOccupancyMaxActiveBlocksPerMultiprocessor(&per_cu, (const void*)mega_fwd, NTHR, 0);
        if (per_cu < 1) { fprintf(stderr, "kernel_launch: occupancy query says %d blocks per CU\n", per_cu); per_cu = 1; }
        grid = cus;
        (void)hipGetLastError();
    }
    if (grid < 0) return;
    hipMemsetAsync((char*)d_ws + WS_CTL, 0, CTL_BYTES, stream);
    Args a{};
    for (int i = 0; i < 20; ++i) a.in[i] = (const float*)d_in[i];
    a.out = (float*)d_out; a.ws = (unsigned char*)d_ws;
#if MK_MULTI
    for (int p = 0; p < NPHASE; ++p) { a.ph_lo = p; a.ph_hi = p + 1; hipLaunchKernelGGL(mega_fwd, dim3(grid), dim3(NTHR), 0, stream, a); }
#else
    a.ph_lo = 0; a.ph_hi = NPHASE;
    void* args[] = {&a};
    hipError_t e = hipLaunchCooperativeKernel((const void*)mega_fwd, dim3(grid), dim3(NTHR), args, 0, stream);
    if (e != hipSuccess) fprintf(stderr, "kernel_launch: cooperative launch failed: %s (grid %d)\n", hipGetErrorString(e), grid);
#endif
}
```

```cpp
#include <hip/hip_runtime.h>
#include <hip/hip_cooperative_groups.h>
#include <cstdio>
#include <cstdint>
namespace cg = cooperative_groups;
namespace pg8 {
#define PG8_LAS __attribute__((address_space(3)))
typedef unsigned short bf16_t;
typedef short bf16x8 __attribute__((ext_vector_type(8)));
typedef float f32x4 __attribute__((ext_vector_type(4)));
typedef unsigned u32x4 __attribute__((ext_vector_type(4)));
constexpr int BM = 256, BK = 64, HALF = 128, HTB = HALF * BK * 2  , STAGE_BYTES = 8 * HTB, NXCD = 8, WGM = 8;

__host__ __device__ __forceinline__ int lds_byte(int r, int c) { const int st = (r >> 4) * 2 + (c >> 5), rr = r & 15, cc = c & 31, ob = rr * 64 + cc * 2; return st * 1024 + (ob ^ (((ob >> 9) & 1) << 5)); }
__host__ __device__ __forceinline__ void stage_rc(int b, int& R, int& C) { const int st = b / 1024, sb = b % 1024, swz = sb ^ (((sb >> 9) & 1) << 5); R = (st >> 1) * 16 + swz / 64; C = (st & 1) * 32 + (swz % 64) / 2; }
__host__ __device__ __forceinline__ int perm32(int rho) { const int n = rho >> 4, i = rho & 15; return 8 * (i >> 2) + 4 * n + (i & 3); }

struct Unit { int pm, pn; };
struct Gemm { const bf16_t* A; const bf16_t* Bt; int M, N, K; };

struct StaticOrder {
    int nM, nN, nwg, G, c;
    __host__ __device__ void init(int M, int N, int G_, int c_) { nM = M / BM; nN = N / BM; nwg = nM * nN; G = G_; c = c_; }
    __host__ __device__ bool next(int i, Unit& u) const {
        const long L = (long)i * G + c; if (L >= nwg) return false;
        int wgid = (int)L; { const int q = nwg / NXCD, r = nwg % NXCD, xcd = wgid % NXCD, off = wgid / NXCD; wgid = (xcd < r ? xcd * (q + 1) : r * (q + 1) + (xcd - r) * q) + off; }
        const int nig = WGM * nN, gid = wgid / nig, fm = gid * WGM, gsz = (nM - fm) < WGM ? (nM - fm) : WGM;
        u.pm = fm + ((wgid % nig) % gsz); u.pn = (wgid % nig) / gsz; return true;
    }
    __device__ __forceinline__ void a_ready(const Unit&) const {}
    __device__ __forceinline__ void done(const Unit&) const {}
};

__device__ __forceinline__ unsigned cvt_pk_bf16(float lo, float hi) { unsigned r; asm volatile("v_cvt_pk_bf16_f32 %0, %1, %2" : "=v"(r) : "v"(lo), "v"(hi)); return r; }
typedef float f32x2 __attribute__((ext_vector_type(2)));
template <class Epi, class Sched, bool ALIGN_EPI = false, bool SP2 = false>
__device__ __forceinline__ void gemm_phase(PG8_LAS unsigned char* lds, const Gemm g, const Sched& S, const Epi& E) {
    int tid_ = threadIdx.x; asm volatile("" : "+v"(tid_)); const int tid = tid_, wid = __builtin_amdgcn_readfirstlane(tid >> 6), lane = tid & 63, wr = wid >> 2, wc = wid & 3, fr = lane & 15, fq = lane >> 4;
    const int K = g.K, nt = K / BK;
    unsigned voffA[2], voffB[2];
#pragma unroll
    for (int i = 0; i < 2; ++i) { int R, C; stage_rc(tid * 16 + i * 8192, R, C); const int Rb = Epi::PERM ? ((R & ~31) + perm32(R & 31)) : R;
        voffA[i] = (unsigned)(R * K + C) * 2u; voffB[i] = (unsigned)(Rb * K + C) * 2u; }
    const size_t kstep = (size_t)(BK * 2);
    const size_t hstep = (size_t)HALF * K * 2;
    const size_t tstep = 2 * hstep;
    const unsigned ldsw = (unsigned)wid * 1024u;
    const int aoff = lds_byte(wr * 64 + fr, fq * 8), boff = lds_byte(wc * 32 + fr, fq * 8);
#define PG8_SA(b, h) (((b) * 2 + (h)) * HTB)
#define PG8_SB(b, h) ((4 + (b) * 2 + (h)) * HTB)
#define PG8_STAGE(bufoff, gbase, voff) do { _Pragma("unroll") for (int _i = 0; _i < 2; ++_i) \
        __builtin_amdgcn_global_load_lds((const unsigned*)((const char*)(gbase) + (voff)[_i]), (PG8_LAS unsigned*)(lds + (bufoff) + ldsw + _i * 8192), 16, 0, 0); } while (0)
#define PG8_LDA(dst, b, h) do { _Pragma("unroll") for (int m = 0; m < 4; ++m) _Pragma("unroll") for (int k = 0; k < 2; ++k) dst[m][k] = *(const PG8_LAS bf16x8*)(lds + PG8_SA(b, h) + aoff + m * 2048 + k * 1024); } while (0)
#define PG8_LDB(dst, b, h) do { _Pragma("unroll") for (int n = 0; n < 2; ++n) _Pragma("unroll") for (int k = 0; k < 2; ++k) dst[n][k] = *(const PG8_LAS bf16x8*)(lds + PG8_SB(b, h) + boff + n * 2048 + k * 1024); } while (0)
#define PG8_MMA(ai, bj, At, Bt) do { __builtin_amdgcn_s_setprio(1); _Pragma("unroll") for (int m = 0; m < 4; ++m) _Pragma("unroll") for (int n = 0; n < 2; ++n) _Pragma("unroll") for (int k = 0; k < 2; ++k) \
        acc[ai][bj][m][n] = __builtin_amdgcn_mfma_f32_16x16x32_bf16(Bt[n][k], At[m][k], acc[ai][bj][m][n], 0, 0, 0); __builtin_amdgcn_s_setprio(0); } while (0)
#define PG8_WAIT_V(n) asm volatile("s_waitcnt vmcnt(" #n ")" ::: "memory")
#define PG8_WAIT_L(n) asm volatile("s_waitcnt lgkmcnt(" #n ")" ::: "memory")
#define PG8_BAR __builtin_amdgcn_s_barrier()
#define PG8_SCHED __builtin_amdgcn_sched_barrier(0)
    Unit cur, nxt; int ui = 0;
    if (!S.next(0, cur)) return;
    f32x4 acc[2][2][4][2];
#pragma unroll
    for (int a = 0; a < 2; ++a)
#pragma unroll
        for (int b = 0; b < 2; ++b)
#pragma unroll
            for (int m = 0; m < 4; ++m)
#pragma unroll
                for (int n = 0; n < 2; ++n) acc[a][b][m][n] = (f32x4){0.f, 0.f, 0.f, 0.f};
    bf16x8 At[4][2], B0[2][2], B1[2][2];
    const char* cA = (const char*)g.A + (size_t)cur.pm * tstep; const char* cB = (const char*)g.Bt + (size_t)cur.pn * tstep;
    S.a_ready(cur);
    if constexpr (SP2) {
        PG8_STAGE(PG8_SB(0, 0), cB, voffB); PG8_STAGE(PG8_SB(0, 1), cB + hstep, voffB); PG8_STAGE(PG8_SA(0, 0), cA, voffA); PG8_STAGE(PG8_SA(0, 1), cA + hstep, voffA);
        if (wr == 1) PG8_BAR;
        PG8_WAIT_V(2); PG8_BAR;
        PG8_STAGE(PG8_SB(1, 0), cB + kstep, voffB); PG8_STAGE(PG8_SA(1, 0), cA + kstep, voffA); PG8_STAGE(PG8_SB(1, 1), cB + hstep + kstep, voffB);
        PG8_WAIT_V(6); PG8_BAR;
    } else {
        PG8_STAGE(PG8_SB(0, 0), cB, voffB); PG8_STAGE(PG8_SA(0, 0), cA, voffA); PG8_STAGE(PG8_SB(0, 1), cB + hstep, voffB); PG8_STAGE(PG8_SA(0, 1), cA + hstep, voffA);
        if (wr == 1) PG8_BAR;
        PG8_WAIT_V(4); PG8_BAR;
        PG8_STAGE(PG8_SB(1, 0), cB + kstep, voffB); PG8_STAGE(PG8_SA(1, 0), cA + kstep, voffA); PG8_STAGE(PG8_SB(1, 1), cB + hstep + kstep, voffB);
        PG8_WAIT_V(6); PG8_BAR;
    }
    for (;;) {
        const bool has_next = S.next(ui + 1, nxt);
        const char* nA = has_next ? (const char*)g.A + (size_t)nxt.pm * tstep : cA; const char* nB = has_next ? (const char*)g.Bt + (size_t)nxt.pn * tstep : cB;
        for (int t = 0; t < nt; t += 2) {
            const bool last = (t == nt - 2);
            const char* a1 = cA + (size_t)(t + 1) * kstep;
            const char* a2 = last ? nA : cA + (size_t)(t + 2) * kstep; const char* b2 = last ? nB : cB + (size_t)(t + 2) * kstep;
            const char* a3 = a2 + kstep; const char* b3 = b2 + kstep;
            if (last && has_next) S.a_ready(nxt);
            if constexpr (SP2) {
            PG8_LDB(B0, 0, 0); PG8_LDB(B1, 0, 1); PG8_SCHED; PG8_LDA(At, 0, 0); PG8_STAGE(PG8_SA(1, 1), a1 + hstep, voffA);
            PG8_WAIT_V(8); PG8_WAIT_L(0); PG8_BAR; PG8_MMA(0, 0, At, B0); PG8_MMA(0, 1, At, B1); PG8_BAR; PG8_SCHED;
            PG8_LDA(At, 0, 1); PG8_STAGE(PG8_SB(0, 0), b2, voffB); PG8_STAGE(PG8_SB(0, 1), b2 + hstep, voffB); PG8_STAGE(PG8_SA(0, 0), a2, voffA);
            PG8_WAIT_V(8); PG8_WAIT_L(0); PG8_BAR; PG8_MMA(1, 0, At, B0); PG8_MMA(1, 1, At, B1); PG8_BAR; PG8_SCHED;
            PG8_LDB(B0, 1, 0); PG8_LDB(B1, 1, 1); PG8_SCHED; PG8_LDA(At, 1, 0); PG8_STAGE(PG8_SA(0, 1), a2 + hstep, voffA);
            PG8_WAIT_V(8); PG8_WAIT_L(0); PG8_BAR; PG8_MMA(0, 0, At, B0); PG8_MMA(0, 1, At, B1); PG8_BAR; PG8_SCHED;
            PG8_LDA(At, 1, 1); PG8_STAGE(PG8_SB(1, 0), b3, voffB); PG8_STAGE(PG8_SB(1, 1), b3 + hstep, voffB); PG8_STAGE(PG8_SA(1, 0), a3, voffA);
            PG8_WAIT_V(8); PG8_WAIT_L(0); PG8_BAR; PG8_MMA(1, 0, At, B0); PG8_MMA(1, 1, At, B1); PG8_BAR; PG8_SCHED;
            } else {
            PG8_LDB(B0, 0, 0); PG8_SCHED; PG8_LDA(At, 0, 0); PG8_STAGE(PG8_SA(1, 1), a1 + hstep, voffA);
            PG8_WAIT_L(8); PG8_BAR; PG8_WAIT_L(0); PG8_MMA(0, 0, At, B0); PG8_BAR; PG8_SCHED;
            PG8_LDB(B1, 0, 1); PG8_STAGE(PG8_SB(0, 0), b2, voffB);
            PG8_BAR; PG8_WAIT_L(0); PG8_MMA(0, 1, At, B1); PG8_BAR;
            PG8_LDA(At, 0, 1); PG8_STAGE(PG8_SA(0, 0), a2, voffA);
            PG8_BAR; PG8_WAIT_L(0); PG8_MMA(1, 0, At, B0); PG8_BAR; PG8_SCHED;
            PG8_STAGE(PG8_SB(0, 1), b2 + hstep, voffB);
            PG8_WAIT_V(6); PG8_BAR; PG8_MMA(1, 1, At, B1); PG8_BAR;
            PG8_LDB(B0, 1, 0); PG8_SCHED; PG8_LDA(At, 1, 0); PG8_STAGE(PG8_SA(0, 1), a2 + hstep, voffA);
            PG8_WAIT_L(8); PG8_BAR; PG8_WAIT_L(0); PG8_MMA(0, 0, At, B0); PG8_BAR; PG8_SCHED;
            PG8_LDB(B1, 1, 1); PG8_STAGE(PG8_SB(1, 0), b3, voffB);
            PG8_BAR; PG8_WAIT_L(0); PG8_MMA(0, 1, At, B1); PG8_BAR;
            PG8_LDA(At, 1, 1); PG8_STAGE(PG8_SA(1, 0), a3, voffA);
            PG8_BAR; PG8_WAIT_L(0); PG8_MMA(1, 0, At, B0); PG8_BAR; PG8_SCHED;
            PG8_STAGE(PG8_SB(1, 1), b3 + hstep, voffB);
            PG8_WAIT_V(6); PG8_BAR; PG8_MMA(1, 1, At, B1); PG8_BAR;
            }
        }
        if constexpr (ALIGN_EPI) { if (wr == 0) PG8_BAR; }
        if constexpr (!Epi::AFTER_DRAIN) { E(acc, cur, wr, wc, fr, fq); S.done(cur); }
        if (!has_next) break;
#pragma unroll
        for (int a = 0; a < 2; ++a)
#pragma unroll
            for (int b = 0; b < 2; ++b)
#pragma unroll
                for (int m = 0; m < 4; ++m)
#pragma unroll
                    for (int n = 0; n < 2; ++n) acc[a][b][m][n] = (f32x4){0.f, 0.f, 0.f, 0.f};
        cur = nxt; cA = nA; cB = nB; ++ui;
        if constexpr (ALIGN_EPI) { if (wr == 1) PG8_BAR; }
    }
    PG8_WAIT_V(0);
    if constexpr (!ALIGN_EPI) { if (wr == 0) PG8_BAR; }
    PG8_BAR;
    if constexpr (Epi::AFTER_DRAIN) { E.fused(acc, cur, wr, wc, fr, fq, lds, wid, lane); S.done(cur); }
#undef PG8_SA
#undef PG8_SB
#undef PG8_STAGE
#undef PG8_LDA
#undef PG8_LDB
#undef PG8_MMA
#undef PG8_WAIT_V
#undef PG8_WAIT_L
#undef PG8_BAR
#undef PG8_SCHED
}
}

#define DI __device__ __forceinline__
#define LAS __attribute__((address_space(3)))
typedef unsigned short bf16_t;
typedef short bf16x8 __attribute__((ext_vector_type(8)));
typedef short s16x4 __attribute__((ext_vector_type(4)));
typedef short v4i16_t __attribute__((ext_vector_type(4)));
typedef float f32x4 __attribute__((ext_vector_type(4)));
typedef float f32x16 __attribute__((ext_vector_type(16)));
typedef unsigned u32x4 __attribute__((ext_vector_type(4)));
typedef unsigned u32x2 __attribute__((ext_vector_type(2)));

constexpr int BATCH = 2, SEQ = 16384, DM = 1024, NT = BATCH * SEQ, FF = 4096, PLE = 256, QKVW = 3072;
constexpr int NWAVES = 8, NTHR = 512;
constexpr float NORM_EPS = 1e-6f;
constexpr float LOG2E = 1.4426950408889634f;
constexpr float SCL2 = 0.125f * LOG2E;
constexpr size_t MiB = 1u << 20;
constexpr size_t WS_CTL = 0, CTL_BYTES = 65536, CTL_BAR_OFF = 16384;
constexpr size_t WS_WL1 = 1 * MiB, WS_ROPE = 28 * MiB, WS_PB1 = 30 * MiB, WS_KM = 46 * MiB, WS_SEL = 47 * MiB, WS_PML = 49 * MiB;
constexpr size_t WS_QKV = 64 * MiB, WS_ATT = 256 * MiB, WS_HID = 64 * MiB, WS_PP = 64 * MiB, WS_U = 320 * MiB;
constexpr size_t WS_PA = 61 * MiB, WS_PB = 46 * MiB;
constexpr size_t WS_WL0 = 384 * MiB, WS_PB0 = 412 * MiB, WS_PO = 320 * MiB, WS_END = 512 * MiB;
constexpr size_t WO_IN = 0, WO_OUT = 6 * MiB, WO_1 = 8 * MiB, WO_2 = 16 * MiB, WO_G = 24 * MiB, WO_P = 26 * MiB;

struct Args { const float* in[20]; float* out; unsigned char* ws; int ph_lo, ph_hi; };

DI unsigned pk_bf16(float lo, float hi) { typedef float f2 __attribute__((ext_vector_type(2))); typedef __bf16 b2 __attribute__((ext_vector_type(2))); f2 v = {lo, hi}; b2 b = __builtin_convertvector(v, b2); return __builtin_bit_cast(unsigned, b); }
DI float bf_lo(unsigned w) { return __uint_as_float(w << 16); }
DI float bf_hi(unsigned w) { return __uint_as_float(w & 0xffff0000u); }
DI float xhalf(float v) { return __shfl_xor(v, 32); }
DI int crow(int i, int hi) { return (i & 3) + 8 * (i >> 2) + 4 * hi; }
DI f32x16 mfma32(bf16x8 a, bf16x8 b, f32x16 c) { return __builtin_amdgcn_mfma_f32_32x32x16_bf16(a, b, c, 0, 0, 0); }
DI s16x4 tr_read(LAS unsigned char* p) { return __builtin_bit_cast(s16x4, __builtin_amdgcn_ds_read_tr16_b64_v4i16((LAS v4i16_t*)p)); }
DI bf16x8 vfrag(LAS unsigned char* p) { const s16x4 lo = tr_read(p), hi = tr_read(p + 512); return __builtin_shufflevector(lo, hi, 0, 1, 2, 3, 4, 5, 6, 7); }
DI float fexp2(float x) { return __builtin_amdgcn_exp2f(x); }
template <int S> DI bf16x8 packP(const f32x16& p) {
    u32x4 w; w.x = pk_bf16(p[8 * S + 0], p[8 * S + 1]); w.y = pk_bf16(p[8 * S + 2], p[8 * S + 3]); w.z = pk_bf16(p[8 * S + 4], p[8 * S + 5]); w.w = pk_bf16(p[8 * S + 6], p[8 * S + 7]);
    return __builtin_bit_cast(bf16x8, w);
}
DI float wave_sum(float v) {
#pragma unroll
    for (int o = 1; o < 64; o <<= 1) v += __shfl_xor(v, o);
    return v;
}
template <int NO> DI void softmax_step(f32x16& s, float& m, float& l, f32x16 (&o)[NO]) {
    float mx = s[0];
#pragma unroll
    for (int i = 1; i < 16; ++i) mx = fmaxf(mx, s[i]);
    mx = fmaxf(mx, xhalf(mx));
    const float mn = fmaxf(m, mx);
    if (__any(mn > m)) {
        const float al = fexp2(m - mn); l *= al;
#pragma unroll
        for (int t = 0; t < NO; ++t)
#pragma unroll
            for (int i = 0; i < 16; ++i) o[t][i] *= al;
    }
    m = mn;
    float sum = 0.f;
#pragma unroll
    for (int i = 0; i < 16; ++i) { s[i] = fexp2(s[i] - mn); sum += s[i]; }
    l += sum;
}

struct EpiBf16R {
    static constexpr bool PERM = true, AFTER_DRAIN = false;
    bf16_t* O; int ldc; int act; int rope_lo, rope_hi; const float* rope; const float* part;
    DI void operator()(const f32x4 (&acc)[2][2][4][2], const pg8::Unit& u, int wr, int wc, int fr, int fq) const {
        const int row0 = u.pm * 256 + wr * 64 + fr, col0 = u.pn * 256 + wc * 32 + 8 * fq;
        const bool do_rope = (u.pn >= rope_lo) && (u.pn < rope_hi);
        const bool mine = ((wc & 1) == 0) && (fq < 2);
        const float sgn = (fq == 0) ? -1.f : 1.f;
#pragma unroll
        for (int ai = 0; ai < 2; ++ai)
#pragma unroll
            for (int m = 0; m < 4; ++m) {
                const int row = row0 + ai * 128 + m * 16;
                bf16_t* rowp = O + (size_t)row * ldc + col0;
                float rs = 1.f;
                if (part) { const f32x4* pq = (const f32x4*)(part + (size_t)row * 16); const f32x4 t4 = (pq[0] + pq[1]) + (pq[2] + pq[3]); rs = 1.0f / sqrtf(((t4.x + t4.y) + (t4.z + t4.w)) * (1.f / DM) + NORM_EPS); }
                f32x4 c0 = {1.f, 1.f, 1.f, 1.f}, c1 = c0, s0 = {0.f, 0.f, 0.f, 0.f}, s1 = s0;
                if (do_rope && mine) { const float* cs = rope + (size_t)row * 16; c0 = *(const f32x4*)cs; c1 = *(const f32x4*)(cs + 4); s0 = *(const f32x4*)(cs + 8) * sgn; s1 = *(const f32x4*)(cs + 12) * sgn; }
#pragma unroll
                for (int bj = 0; bj < 2; ++bj) {
                    f32x4 v0 = acc[ai][bj][m][0] * rs, v1 = acc[ai][bj][m][1] * rs;
                    if (act == 2) {
#pragma unroll
                        for (int k = 0; k < 4; ++k) { const float a = fmaxf(v0[k], 0.f), b = fmaxf(v1[k], 0.f); v0[k] = a * a; v1[k] = b * b; }
                    }
                    if (do_rope) {
                        f32x4 p0, p1;
#pragma unroll
                        for (int k = 0; k < 4; ++k) { p0[k] = __shfl_xor(v0[k], 16); p1[k] = __shfl_xor(v1[k], 16); }
                        v0 = v0 * c0 + p0 * s0; v1 = v1 * c1 + p1 * s1;
                    }
                    u32x4 w; w.x = pk_bf16(v0[0], v0[1]); w.y = pk_bf16(v0[2], v0[3]); w.z = pk_bf16(v1[0], v1[1]); w.w = pk_bf16(v1[2], v1[3]);
                    *(u32x4*)(rowp + bj * 128) = w;
                }
            }
    }
};
template <bool BASE_BF16> struct EpiRes {
    static constexpr bool PERM = true, AFTER_DRAIN = false;
    const void* base; bf16_t* hb; float* part; int ldc;
    DI void operator()(const f32x4 (&acc)[2][2][4][2], const pg8::Unit& u, int wr, int wc, int fr, int fq) const {
        const int row0 = u.pm * 256 + wr * 64 + fr, col0 = u.pn * 256 + wc * 32 + 8 * fq;
#pragma unroll
        for (int ai = 0; ai < 2; ++ai)
#pragma unroll
            for (int m = 0; m < 4; ++m) {
                const int row = row0 + ai * 128 + m * 16;
                const size_t off = (size_t)row * ldc + col0;
                float ss = 0.f;
#pragma unroll
                for (int bj = 0; bj < 2; ++bj) {
                    const size_t o2 = off + bj * 128;
                    f32x4 b0, b1v;
                    if (BASE_BF16) { const u32x4 bw = *(const u32x4*)((const bf16_t*)base + o2); b0 = (f32x4){bf_lo(bw.x), bf_hi(bw.x), bf_lo(bw.y), bf_hi(bw.y)}; b1v = (f32x4){bf_lo(bw.z), bf_hi(bw.z), bf_lo(bw.w), bf_hi(bw.w)}; }
                    else { b0 = *(const f32x4*)((const float*)base + o2); b1v = *(const f32x4*)((const float*)base + o2 + 4); }
                    const f32x4 r0 = b0 + acc[ai][bj][m][0], r1 = b1v + acc[ai][bj][m][1];
                    u32x4 w; w.x = pk_bf16(r0[0], r0[1]); w.y = pk_bf16(r0[2], r0[3]); w.z = pk_bf16(r1[0], r1[1]); w.w = pk_bf16(r1[2], r1[3]);
                    *(u32x4*)(hb + o2) = w;
                    ss += ((r0[0] * r0[0] + r0[1] * r0[1]) + (r0[2] * r0[2] + r0[3] * r0[3])) + ((r1[0] * r1[0] + r1[1] * r1[1]) + (r1[2] * r1[2] + r1[3] * r1[3]));
                }
                ss += __shfl_xor(ss, 16); ss += __shfl_xor(ss, 32);
                if (fq == 0) part[(size_t)row * 16 + u.pn * 4 + wc] = ss;
            }
    }
};
struct EpiPle {
    static constexpr bool PERM = true, AFTER_DRAIN = false;
    const bf16_t* base; const bf16_t* pp; const float* partin; bf16_t* hb; float* part; int ldc;
    DI void operator()(const f32x4 (&acc)[2][2][4][2], const pg8::Unit& u, int wr, int wc, int fr, int fq) const {
        const int row0 = u.pm * 256 + wr * 64 + fr, col0 = u.pn * 256 + wc * 32 + 8 * fq;
#pragma unroll
        for (int ai = 0; ai < 2; ++ai)
#pragma unroll
            for (int m = 0; m < 4; ++m) {
                const int row = row0 + ai * 128 + m * 16;
                const size_t off = (size_t)row * ldc + col0;
                const f32x4* pq = (const f32x4*)(partin + (size_t)row * 16); const f32x4 t4 = (pq[0] + pq[1]) + (pq[2] + pq[3]);
                const float rs = -1.0f / sqrtf(((t4.x + t4.y) + (t4.z + t4.w)) * (1.f / DM) + NORM_EPS);
                float ss = 0.f;
#pragma unroll
                for (int bj = 0; bj < 2; ++bj) {
                    const size_t o2 = off + bj * 128;
                    const u32x4 pw = *(const u32x4*)(pp + o2), bw = *(const u32x4*)(base + o2);
                    const f32x4 a0 = acc[ai][bj][m][0] * rs, a1 = acc[ai][bj][m][1] * rs;
                    f32x4 r0, r1;
                    r0[0] = bf_lo(bw.x) + bf_lo(pw.x) / (1.f + __expf(a0[0])); r0[1] = bf_hi(bw.x) + bf_hi(pw.x) / (1.f + __expf(a0[1]));
                    r0[2] = bf_lo(bw.y) + bf_lo(pw.y) / (1.f + __expf(a0[2])); r0[3] = bf_hi(bw.y) + bf_hi(pw.y) / (1.f + __expf(a0[3]));
                    r1[0] = bf_lo(bw.z) + bf_lo(pw.z) / (1.f + __expf(a1[0])); r1[1] = bf_hi(bw.z) + bf_hi(pw.z) / (1.f + __expf(a1[1]));
                    r1[2] = bf_lo(bw.w) + bf_lo(pw.w) / (1.f + __expf(a1[2])); r1[3] = bf_hi(bw.w) + bf_hi(pw.w) / (1.f + __expf(a1[3]));
                    u32x4 w; w.x = pk_bf16(r0[0], r0[1]); w.y = pk_bf16(r0[2], r0[3]); w.z = pk_bf16(r1[0], r1[1]); w.w = pk_bf16(r1[2], r1[3]);
                    *(u32x4*)(hb + o2) = w;
                    ss += ((r0[0] * r0[0] + r0[1] * r0[1]) + (r0[2] * r0[2] + r0[3] * r0[3])) + ((r1[0] * r1[0] + r1[1] * r1[1]) + (r1[2] * r1[2] + r1[3] * r1[3]));
                }
                ss += __shfl_xor(ss, 16); ss += __shfl_xor(ss, 32);
                if (fq == 0) part[(size_t)row * 16 + u.pn * 4 + wc] = ss;
            }
    }
};

DI void final_row(const bf16_t* hrow, const float* prow, const float* g, float* orow, int lane) {
    const float pv = (lane < 16) ? prow[lane] : 0.f;
    const float r = 1.0f / sqrtf(wave_sum(pv) * (1.f / DM) + NORM_EPS);
#pragma unroll
    for (int j = 0; j < 2; ++j) {
        const int c0 = j * 512 + lane * 8;
        const u32x4 w = *(const u32x4*)(hrow + c0);
        const f32x4 g0 = *(const f32x4*)(g + c0), g1 = *(const f32x4*)(g + c0 + 4);
        *(f32x4*)(orow + c0) = (f32x4){bf_lo(w.x) * r * g0.x, bf_hi(w.x) * r * g0.y, bf_lo(w.y) * r * g0.z, bf_hi(w.y) * r * g0.w};
        *(f32x4*)(orow + c0 + 4) = (f32x4){bf_lo(w.z) * r * g1.x, bf_hi(w.z) * r * g1.y, bf_lo(w.w) * r * g1.z, bf_hi(w.w) * r * g1.w};
    }
}
DI void transpose_item(const float* W, const float* g, int K, int N, bf16_t* WT, float* scr, int item, int lane) {
    const int nblk = N / 64, kb = item / nblk, nb = item % nblk, k0 = 64 * kb, n0 = 64 * nb;
    const int lr = lane >> 4, lc = (lane & 15) * 4;
#pragma unroll 8
    for (int i = 0; i < 16; ++i) {
        const int kk = 4 * i + lr; const float gv = g ? g[k0 + kk] : 1.f;
        const f32x4 v = *(const f32x4*)(W + (size_t)(k0 + kk) * N + n0 + lc);
        float* d = scr + kk * 65 + lc; d[0] = v.x * gv; d[1] = v.y * gv; d[2] = v.z * gv; d[3] = v.w * gv;
    }
    asm volatile("s_waitcnt lgkmcnt(0)" ::: "memory");
    const int c = lane & 7;
#pragma unroll
    for (int j = 0; j < 8; ++j) {
        const int n = (lane >> 3) + 8 * j; const float* s = scr + (8 * c) * 65 + n;
        u32x4 o; o.x = pk_bf16(s[0 * 65], s[1 * 65]); o.y = pk_bf16(s[2 * 65], s[3 * 65]); o.z = pk_bf16(s[4 * 65], s[5 * 65]); o.w = pk_bf16(s[6 * 65], s[7 * 65]);
        *(u32x4*)(WT + (size_t)(n0 + n) * K + k0 + 8 * c) = o;
    }
    asm volatile("s_waitcnt lgkmcnt(0)" ::: "memory");
}
#define GAS __attribute__((address_space(1)))
#define RLX_AGENT __ATOMIC_RELAXED, __HIP_MEMORY_SCOPE_AGENT
#define XB_TMO      128
#define XB_XCNT(j)  (256  + 64 * (j))
#define XB_XSUB(j)  (1280 + 64 * (j))
#define XB_XGEN(j)  (2304 + 64 * (j))
#define XB_TOP      3328
#define XB_TOPGEN   3392
#define XCD_BAR_WORDS 3456
#define XB_SPIN_CAP (1u << 18)

__device__ __forceinline__ unsigned xb_ld(unsigned* p)              { return __hip_atomic_load(p, __ATOMIC_RELAXED, __HIP_MEMORY_SCOPE_AGENT); }
__device__ __forceinline__ unsigned xb_add(unsigned* p, unsigned v) { return __hip_atomic_fetch_add(p, v, __ATOMIC_RELAXED, __HIP_MEMORY_SCOPE_AGENT); }
__device__ __forceinline__ unsigned xb_xcc_id() { return (unsigned)__builtin_amdgcn_s_getreg((3 << 11) | 20) & 0xFu; }
#define XB_SPIN(cond, bar) do { unsigned _sp = 0; while (cond) { __builtin_amdgcn_s_sleep(1); \
    if ((++_sp & 255u) == 0u) { if (xb_ld(&(bar)[XB_TMO])) break; if (_sp > XB_SPIN_CAP) { atomicAdd(&(bar)[XB_TMO], 1u); break; } } } } while (0)

struct XcdBarrier {
    unsigned* bar; unsigned x;
    volatile LAS unsigned* st;
};

__device__ __forceinline__ XcdBarrier xcd_barrier_post(unsigned* bar, volatile LAS unsigned* st) {
    XcdBarrier b; b.bar = bar; b.x = xb_xcc_id(); b.st = st;
    if (threadIdx.x == 0) (void)xb_add(&bar[XB_XCNT(b.x)], 1u);
    return b;
}
__device__ __forceinline__ void xcd_barrier_complete(unsigned* bar, unsigned x, unsigned& nloc, unsigned& nx) {
    const unsigned G = gridDim.x * gridDim.y * gridDim.z;
    unsigned sum, cnt, mine, sp = 0u;
    for (;;) {
        sum = 0u; cnt = 0u; mine = 0u;
#pragma unroll
        for (unsigned j = 0; j < 16; ++j) { const unsigned c = xb_ld(&bar[XB_XCNT(j)]); sum += c; cnt += (c > 0u) ? 1u : 0u; mine = (j == x) ? c : mine; }
        if (sum == G) break;
        __builtin_amdgcn_s_sleep(1);
        if ((++sp & 255u) == 0u) { if (xb_ld(&bar[XB_TMO])) break; if (sp > XB_SPIN_CAP) { atomicAdd(&bar[XB_TMO], 1u); break; } }
    }
    nloc = mine > 0u ? mine : 1u; nx = cnt > 0u ? cnt : 1u;
}

__device__ __forceinline__ void xcd_barrier(const XcdBarrier& b) {
    asm volatile("s_waitcnt vmcnt(0)" ::: "memory");
    __syncthreads();
    if (threadIdx.x == 0) {
        unsigned* bar = b.bar;
        __builtin_amdgcn_s_waitcnt(0);
        unsigned nloc = b.st[0], nx = b.st[1];
        if (nloc == 0u) { xcd_barrier_complete(bar, b.x, nloc, nx); b.st[0] = nloc; b.st[1] = nx; }
        const unsigned old = xb_add(&bar[XB_XSUB(b.x)], 1u);
        const unsigned gen = old / nloc;
        if (old + 1u == (gen + 1u) * nloc) {
            __builtin_amdgcn_fence(__ATOMIC_RELEASE, "agent");
            asm volatile("s_waitcnt vmcnt(0)" ::: "memory");
            const unsigned og = xb_add(&bar[XB_TOP], 1u);
            const unsigned tg = og / nx;
            if (og + 1u == (tg + 1u) * nx) xb_add(&bar[XB_TOPGEN], 1u);
            else XB_SPIN(xb_ld(&bar[XB_TOPGEN]) == tg, bar);
            __builtin_amdgcn_fence(__ATOMIC_ACQUIRE, "agent");
            xb_add(&bar[XB_XGEN(b.x)], 1u);
            asm volatile("s_waitcnt vmcnt(0)" ::: "memory");
        } else {
            XB_SPIN(xb_ld(&bar[XB_XGEN(b.x)]) == gen, bar);
            __builtin_amdgcn_fence(__ATOMIC_ACQUIRE, "agent");
            asm volatile("s_waitcnt vmcnt(0)" ::: "memory");
        }
    }
    __syncthreads();
}

DI void sb_unit(const bf16_t* QKV, bf16_t* ATT, LAS unsigned char* lds3, int b, int head, int qb, int wid, int lane) {
    const int r32 = lane & 31, hi = lane >> 5;
    const size_t rowbase = (size_t)b * SEQ;
    const int q0 = qb * 256 + wid * 32;
    const int qcol = head * 64, kcol = 512 + head * 64, vcol = 1024 + head * 64;
    bf16x8 qf[4];
#pragma unroll
    for (int c = 0; c < 4; ++c) qf[c] = *(const bf16x8*)(QKV + (rowbase + q0 + r32) * QKVW + qcol + 16 * c + 8 * hi);
    f32x16 o[2];
#pragma unroll
    for (int i = 0; i < 16; ++i) { o[0][i] = 0.f; o[1][i] = 0.f; }
    float carry = 0.f;
    LAS unsigned char* vimg = lds3 + wid * 4096;
    LAS unsigned char* vrd = vimg + (4 * hi + ((lane & 15) >> 2)) * 64 + ((lane >> 4) & 1) * 32 + (lane & 3) * 8;
    bf16x8 kf[4]; u32x4 vv[4];
#define SB_LOAD(K0) do { _Pragma("unroll") for (int c = 0; c < 4; ++c) kf[c] = *(const bf16x8*)(QKV + (rowbase + (K0) + r32) * QKVW + kcol + 16 * c + 8 * hi); \
        _Pragma("unroll") for (int i = 0; i < 4; ++i) { const int id = lane + 64 * i, key = id >> 3, ch = id & 7; vv[i] = *(const u32x4*)(QKV + (rowbase + (K0) + key) * QKVW + vcol + ch * 8); } } while (0)
    SB_LOAD(q0);
    for (int k0 = q0; k0 >= 0; k0 -= 32) {
        const bf16x8 kc0 = kf[0], kc1 = kf[1], kc2 = kf[2], kc3 = kf[3];
#pragma unroll
        for (int i = 0; i < 4; ++i) { const int id = lane + 64 * i, key = id >> 3, ch = id & 7; *(LAS u32x4*)(vimg + (ch >> 2) * 2048 + key * 64 + (ch & 3) * 16) = vv[i]; }
        if (k0 >= 32) SB_LOAD(k0 - 32);
        f32x16 s;
#pragma unroll
        for (int i = 0; i < 16; ++i) s[i] = 0.f;
        s = mfma32(kc0, qf[0], s); s = mfma32(kc1, qf[1], s); s = mfma32(kc2, qf[2], s); s = mfma32(kc3, qf[3], s);
        const int qpos = q0 + r32;
        float lk[16];
#pragma unroll
        for (int i = 0; i < 16; ++i) {
            const float z = s[i] * 0.125f;
            const bool past = (k0 + crow(i, hi)) < qpos;
            const float sp = fmaxf(z, 0.f) + __logf(1.f + __expf(-fabsf(z)));
            lk[i] = past ? -sp : 0.f;
            s[i] = past ? z : -INFINITY;
        }
        float gs[4], go[4];
#pragma unroll
        for (int g = 0; g < 4; ++g) { gs[g] = (lk[4 * g] + lk[4 * g + 1]) + (lk[4 * g + 2] + lk[4 * g + 3]); go[g] = xhalf(gs[g]); }
        const float ps0 = gs[0] + go[0], ps1 = gs[1] + go[1], ps2 = gs[2] + go[2], ps3 = gs[3] + go[3];
        float ap[4]; ap[3] = 0.f; ap[2] = ps3; ap[1] = ps3 + ps2; ap[0] = ps3 + ps2 + ps1;
#pragma unroll
        for (int g = 0; g < 4; ++g) {
            const float aft = carry + ap[g] + (hi == 0 ? go[g] : 0.f);
            const float w3 = aft, w2 = aft + lk[4 * g + 3], w1 = w2 + lk[4 * g + 2], w0 = w1 + lk[4 * g + 1];
            s[4 * g + 3] = __expf(s[4 * g + 3] + lk[4 * g + 3] + w3);
            s[4 * g + 2] = __expf(s[4 * g + 2] + lk[4 * g + 2] + w2);
            s[4 * g + 1] = __expf(s[4 * g + 1] + lk[4 * g + 1] + w1);
            s[4 * g + 0] = __expf(s[4 * g + 0] + lk[4 * g + 0] + w0);
        }
        carry += (ps0 + ps1) + (ps2 + ps3);
        const bf16x8 p0 = packP<0>(s), p1 = packP<1>(s);
        asm volatile("s_waitcnt lgkmcnt(0)" ::: "memory");
#pragma unroll
        for (int dt = 0; dt < 2; ++dt) {
            const bf16x8 v0 = vfrag(vrd + dt * 2048), v1 = vfrag(vrd + dt * 2048 + 1024);
            o[dt] = mfma32(v0, p0, o[dt]); o[dt] = mfma32(v1, p1, o[dt]);
        }
        asm volatile("s_waitcnt lgkmcnt(0)" ::: "memory");
        if (__all(carry < -104.f)) break;
    }
#undef SB_LOAD
    bf16_t* op = ATT + (rowbase + q0 + r32) * DM + head * 64;
#pragma unroll
    for (int dt = 0; dt < 2; ++dt)
#pragma unroll
        for (int g = 0; g < 4; ++g) { u32x2 w; w.x = pk_bf16(o[dt][4 * g], o[dt][4 * g + 1]); w.y = pk_bf16(o[dt][4 * g + 2], o[dt][4 * g + 3]); *(u32x2*)(op + 32 * dt + 8 * g + 4 * hi) = w; }
}

constexpr int DF_STAGE = 32768, DF_K2 = 8192, DF_V = 16384;
DI void glds16s(const void* sbase, unsigned voff, unsigned lds_dst) { unsigned keep;
    asm volatile("s_mov_b32 %0, m0\n\ts_mov_b32 m0, %3\n\ts_nop 0\n\tglobal_load_lds_dwordx4 %1, %2\n\ts_mov_b32 m0, %0" : "=&s"(keep) : "v"(voff), "s"(sbase), "s"(lds_dst) : "memory"); }
#define DF_VLD(VF, VOFF, H) do { _Pragma("unroll") for (int d2 = 0; d2 < 2; ++d2) { LAS unsigned char* vb_ = lds3 + (VOFF) + (2 * (H) + d2) * 4096; VF[2 * d2] = vfrag(vb_); VF[2 * d2 + 1] = vfrag(vb_ + 1024); } } while (0)
#define DF_PVM(VF, P0, P1, H) do { _Pragma("unroll") for (int d2 = 0; d2 < 2; ++d2) { o[2 * (H) + d2] = mfma32(VF[2 * d2], P0, o[2 * (H) + d2]); o[2 * (H) + d2] = mfma32(VF[2 * d2 + 1], P1, o[2 * (H) + d2]); } } while (0)
DI void diff_stage(const unsigned char* lds, LAS unsigned char* lds3, int buf, int t, int comp, int q0, int r32, int hi, int vlane, bool skew,
                   const bf16x8 (&qf)[4], f32x16 (&o)[4], float& m, float& l, bf16x8 (&pp)[4], int& pvo, bool& have_prev) {
    const int k0 = 64 * t;
    if (k0 > q0 + 31) return;
    const unsigned char* sb = lds + buf * DF_STAGE + comp * DF_K2 + r32 * 128; const int ke16 = (hi ^ ((r32 >> 1) & 7)) * 16;
    bf16x8 vf[4];
    if (skew && have_prev) {
#pragma unroll
        for (int sub = 0; sub < 2; ++sub) { DF_VLD(vf, pvo + sub * 2048, 0); DF_PVM(vf, pp[2 * sub], pp[2 * sub + 1], 0); DF_VLD(vf, pvo + sub * 2048, 1); DF_PVM(vf, pp[2 * sub], pp[2 * sub + 1], 1); }
    }
    f32x16 s0, s1;
#pragma unroll
    for (int i = 0; i < 16; ++i) { s0[i] = 0.f; s1[i] = 0.f; }
    {
        bf16x8 k0f[4], k1f[4];
#pragma unroll
        for (int c = 0; c < 4; ++c) { k0f[c] = *(const bf16x8*)(sb + ((32 * c) ^ ke16)); k1f[c] = *(const bf16x8*)(sb + 32 * 128 + ((32 * c) ^ ke16)); }
#pragma unroll
        for (int c = 0; c < 4; ++c) { s0 = mfma32(k0f[c], qf[c], s0); s1 = mfma32(k1f[c], qf[c], s1); }
    }
    if (k0 + 63 > q0) {
        const int dq = q0 + r32 - k0 - 4 * hi;
#pragma unroll
        for (int i = 0; i < 16; ++i) { const int ci = (i & 3) + 8 * (i >> 2); s0[i] = (ci > dq) ? -INFINITY : s0[i]; s1[i] = (ci + 32 > dq) ? -INFINITY : s1[i]; }
    }
    float mx = fmaxf(fmaxf(s0[0], s0[1]), s1[0]);
#pragma unroll
    for (int i = 1; i < 15; i += 2) { mx = fmaxf(fmaxf(mx, s0[i + 1]), s0[i + 2 > 15 ? 15 : i + 2]); mx = fmaxf(fmaxf(mx, s1[i]), s1[i + 1]); }
    mx = fmaxf(mx, s1[15]);
    mx = fmaxf(mx, xhalf(mx)) * SCL2;
    if (__any(mx > m + 8.f)) {
        const float mn = fmaxf(m, mx), al = fexp2(m - mn); l *= al; m = mn;
#pragma unroll
        for (int dt = 0; dt < 4; ++dt)
#pragma unroll
            for (int i = 0; i < 16; ++i) o[dt][i] *= al;
    }
    float sum0 = 0.f, sum1 = 0.f;
#pragma unroll
    for (int i = 0; i < 16; ++i) { s0[i] = fexp2(__builtin_fmaf(s0[i], SCL2, -m)); sum0 += s0[i]; s1[i] = fexp2(__builtin_fmaf(s1[i], SCL2, -m)); sum1 += s1[i]; }
    l += sum0 + sum1;
    const int vo = buf * DF_STAGE + DF_V + vlane;
    if (!skew) {
        const bf16x8 p00 = packP<0>(s0), p01 = packP<1>(s0);
        DF_VLD(vf, vo, 0); DF_PVM(vf, p00, p01, 0); DF_VLD(vf, vo, 1); DF_PVM(vf, p00, p01, 1);
        const bf16x8 p10 = packP<0>(s1), p11 = packP<1>(s1);
        DF_VLD(vf, vo + 2048, 0); DF_PVM(vf, p10, p11, 0); DF_VLD(vf, vo + 2048, 1); DF_PVM(vf, p10, p11, 1);
    } else { pp[0] = packP<0>(s0); pp[1] = packP<1>(s0); pp[2] = packP<0>(s1); pp[3] = packP<1>(s1); pvo = vo; have_prev = true; }
}
DI void diff_unit(const Args& A, const bf16_t* QKV, bf16_t* ATT, unsigned char* lds, LAS unsigned char* lds3, int b, int head, int qb, int tid, int wid, int lane) {
    const int r32 = lane & 31, hi = lane >> 5, comp = wid >> 2, wq = wid & 3;
    const size_t rowbase = (size_t)b * SEQ;
    const int q0 = qb * 128 + wq * 32;
    const int qcol = 1536 + head * 128 + comp * 64;
    bf16x8 qf[4];
#pragma unroll
    for (int c = 0; c < 4; ++c) qf[c] = *(const bf16x8*)(QKV + (rowbase + q0 + r32) * QKVW + qcol + 16 * c + 8 * hi);
    f32x16 o[4];
#pragma unroll
    for (int t = 0; t < 4; ++t)
#pragma unroll
        for (int i = 0; i < 16; ++i) o[t][i] = 0.f;
    float m = -INFINITY, l = 0.f;
    const int nst = 2 * (qb + 1);
    const unsigned ldsb = (unsigned)(uintptr_t)lds3;
    const int kkey = 8 * wid + (lane >> 3), kch = (lane & 7) ^ ((kkey >> 1) & 7);
    const int vi0 = 2 * wid, vi1 = 2 * wid + 1;
    const bf16_t* sbase = QKV + rowbase * QKVW + head * 128;
    const unsigned oK = (unsigned)((kkey * QKVW + 2048 + kch * 8) * 2);
    const unsigned oV0 = (unsigned)(((16 * (vi0 & 3) + (lane >> 2)) * QKVW + 2560 + ((vi0 >> 2) * 4 + (lane & 3)) * 8) * 2);
    const unsigned oV1 = (unsigned)(((16 * (vi1 & 3) + (lane >> 2)) * QKVW + 2560 + ((vi1 >> 2) * 4 + (lane & 3)) * 8) * 2);
    const unsigned dK = (unsigned)__builtin_amdgcn_readfirstlane(wid * 1024);
    const unsigned dV0 = (unsigned)__builtin_amdgcn_readfirstlane(DF_V + (vi0 >> 2) * 4096 + (vi0 & 3) * 1024), dV1 = (unsigned)__builtin_amdgcn_readfirstlane(DF_V + (vi1 >> 2) * 4096 + (vi1 & 3) * 1024);
#define DF_DMA(t, bufi) do { const bf16_t* sb_ = sbase + (size_t)(64 * (t)) * QKVW; const unsigned base_ = (unsigned)__builtin_amdgcn_readfirstlane(ldsb + (bufi) * DF_STAGE); \
        glds16s(sb_, oK, base_ + dK); glds16s(sb_, oK + 128u, base_ + DF_K2 + dK); glds16s(sb_, oV0, base_ + dV0); glds16s(sb_, oV1, base_ + dV1); } while (0)
#define DF_WAITBAR(N) asm volatile("s_waitcnt vmcnt(" #N ") lgkmcnt(0)\n\ts_barrier" ::: "memory")
    DF_DMA(0, 0); DF_DMA(1, 1);
    asm volatile("" : "+v"(qf[0]), "+v"(qf[1]), "+v"(qf[2]), "+v"(qf[3]));
    DF_WAITBAR(4);
    const int vlane = (4 * hi + ((lane & 15) >> 2)) * 64 + ((lane >> 4) & 1) * 32 + (lane & 3) * 8;
    const bool skew = false;
    bf16x8 pp[4]; { const bf16x8 z8 = {0, 0, 0, 0, 0, 0, 0, 0}; pp[0] = z8; pp[1] = z8; pp[2] = z8; pp[3] = z8; } int pvo = vlane; bool have_prev = false;
    for (int t = 0; t < nst; ++t) {
        { const int tl = (t + 2 < nst) ? t + 2 : nst - 1; DF_DMA(tl, (t + 2) & 3); }
        diff_stage(lds, lds3, t & 3, t, comp, q0, r32, hi, vlane, skew, qf, o, m, l, pp, pvo, have_prev);
        DF_WAITBAR(4);
    }
    asm volatile("s_waitcnt vmcnt(0)" ::: "memory");
#undef DF_DMA
#undef DF_WAITBAR
    if (skew && have_prev) { bf16x8 vf[4];
#pragma unroll
        for (int sub = 0; sub < 2; ++sub) { DF_VLD(vf, pvo + sub * 2048, 0); DF_PVM(vf, pp[2 * sub], pp[2 * sub + 1], 0); DF_VLD(vf, pvo + sub * 2048, 1); DF_PVM(vf, pp[2 * sub], pp[2 * sub + 1], 1); } }
    __syncthreads();
    float lam;
    {
        const float* lq1 = A.in[6] + head * 64; const float* lk1 = A.in[7] + head * 64; const float* lq2 = A.in[8] + head * 64; const float* lk2 = A.in[9] + head * 64;
        const float d1 = wave_sum(lq1[lane] * lk1[lane]), d2 = wave_sum(lq2[lane] * lk2[lane]);
        lam = __expf(d1) - __expf(d2) + 0.2f;
    }
    const float inv = 1.f / (l + xhalf(l));
    float* X = (float*)lds;
    if (comp == 1) {
#pragma unroll
        for (int t = 0; t < 4; ++t)
#pragma unroll
            for (int i = 0; i < 16; ++i) X[(wq * 64 + t * 16 + i) * 64 + lane] = o[t][i] * inv;
    }
    __syncthreads();
    if (comp == 0) {
        float ss = 0.f;
#pragma unroll
        for (int t = 0; t < 4; ++t)
#pragma unroll
            for (int i = 0; i < 16; ++i) { const float v = o[t][i] * inv - lam * X[(wq * 64 + t * 16 + i) * 64 + lane]; o[t][i] = v; ss += v * v; }
        ss += xhalf(ss);
        const float r = 0.8f / sqrtf(ss * (1.f / 128.f) + NORM_EPS);
        const float* g = A.in[10];
        bf16_t* op = ATT + (rowbase + q0 + r32) * DM + 512 + head * 128;
#pragma unroll
        for (int t = 0; t < 4; ++t)
#pragma unroll
            for (int gq = 0; gq < 4; ++gq) {
                const int d = 32 * t + 8 * gq + 4 * hi; const f32x4 gg = *(const f32x4*)(g + d);
                u32x2 w; w.x = pk_bf16(o[t][4 * gq] * r * gg.x, o[t][4 * gq + 1] * r * gg.y); w.y = pk_bf16(o[t][4 * gq + 2] * r * gg.z, o[t][4 * gq + 3] * r * gg.w);
                *(u32x2*)(op + d) = w;
            }
    }
    __syncthreads();
}
#undef DF_VLD
#undef DF_PVM

DI void phase_attn0(const Args& A, unsigned char* lds, LAS unsigned char* lds3, int tid, int wid, int lane) {
    const bf16_t* QKV = (const bf16_t*)(A.ws + WS_QKV); bf16_t* ATT = (bf16_t*)(A.ws + WS_ATT);
    const int G = gridDim.x;
    for (int pi = blockIdx.x; pi < 512; pi += G) {
        const int pid = (G == 256) ? ((pi & 7) * 64 + ((pi >> 3) & 31) + (pi >> 8) * 32) : pi;
        const int bh = pid >> 6, s = pid & 63, b = bh >> 2, head = bh & 3;
        diff_unit(A, QKV, ATT, lds, lds3, b, head, 127 - s, tid, wid, lane);
        diff_unit(A, QKV, ATT, lds, lds3, b, head, s, tid, wid, lane);
    }
}
DI void phase_attn0_sb(const Args& A, LAS unsigned char* lds3, int wid, int lane) {
    const bf16_t* QKV = (const bf16_t*)(A.ws + WS_QKV); bf16_t* ATT = (bf16_t*)(A.ws + WS_ATT);
    const int G = gridDim.x;
    for (int u = blockIdx.x; u < 1024; u += G) {
        const int bh = u >> 6, qb = u & 63, b = bh >> 3, head = bh & 7;
        sb_unit(QKV, ATT, lds3, b, head, qb, wid, lane);
    }
}


DI void phase_kmean(const Args& A, int gw, int ngw, int lane) {
    const bf16_t* QKV = (const bf16_t*)(A.ws + WS_QKV); float* KM = (float*)(A.ws + WS_KM);
    for (int u = gw; u < BATCH * 16 * 64; u += ngw) {
        const int blk = u & 63, bh = u >> 6, b = bh >> 4, h = bh & 15;
        const int ch = lane & 7, sub = lane >> 3;
        float acc[8];
#pragma unroll
        for (int k = 0; k < 8; ++k) acc[k] = 0.f;
        const bf16_t* base = QKV + ((size_t)b * SEQ + blk * 256 + sub) * QKVW + 1024 + h * 64 + ch * 8;
#pragma unroll 4
        for (int it = 0; it < 32; ++it) {
            const u32x4 w = *(const u32x4*)(base + (size_t)it * 8 * QKVW);
            acc[0] += bf_lo(w.x); acc[1] += bf_hi(w.x); acc[2] += bf_lo(w.y); acc[3] += bf_hi(w.y); acc[4] += bf_lo(w.z); acc[5] += bf_hi(w.z); acc[6] += bf_lo(w.w); acc[7] += bf_hi(w.w);
        }
#pragma unroll
        for (int k = 0; k < 8; ++k) { float v = acc[k]; v += __shfl_xor(v, 8); v += __shfl_xor(v, 16); v += __shfl_xor(v, 32); acc[k] = v * (1.f / 256.f); }
        if (lane < 8) { float* o = KM + (size_t)u * 64 + ch * 8; *(f32x4*)o = (f32x4){acc[0], acc[1], acc[2], acc[3]}; *(f32x4*)(o + 4) = (f32x4){acc[4], acc[5], acc[6], acc[7]}; }
    }
}
DI void top3_insert(float v, int idx, float& v1, int& i1, float& v2, int& i2, float& v3, int& i3) {
    const bool b1 = (v > v1) || (v == v1 && idx < i1), b2 = (v > v2) || (v == v2 && idx < i2), b3 = (v > v3) || (v == v3 && idx < i3);
    const float nv3 = b2 ? v2 : (b3 ? v : v3), nv2 = b1 ? v1 : (b2 ? v : v2), nv1 = b1 ? v : v1;
    const int ni3 = b2 ? i2 : (b3 ? idx : i3), ni2 = b1 ? i1 : (b2 ? idx : i2), ni1 = b1 ? idx : i1;
    v1 = nv1; v2 = nv2; v3 = nv3; i1 = ni1; i2 = ni2; i3 = ni3;
}
DI void phase_gate(const Args& A, int gw, int ngw, int lane) {
    const bf16_t* QKV = (const bf16_t*)(A.ws + WS_QKV); const float* KM = (const float*)(A.ws + WS_KM); unsigned* SEL = (unsigned*)(A.ws + WS_SEL);
    const int r32 = lane & 31, hi = lane >> 5;
    for (int u = gw; u < BATCH * 16 * 512; u += ngw) {
        const int qt = u & 511, bh = u >> 9, b = bh >> 4, h = bh & 15;
        const int own = qt >> 3;
        const size_t srow = (size_t)bh * SEQ + qt * 32 + r32;
        if (own == 0) { if (hi == 0) SEL[srow] = 0xffffffffu; continue; }
        bf16x8 qf[4];
#pragma unroll
        for (int c = 0; c < 4; ++c) qf[c] = *(const bf16x8*)(QKV + ((size_t)b * SEQ + qt * 32 + r32) * QKVW + h * 64 + 16 * c + 8 * hi);
        float v1 = -INFINITY, v2 = -INFINITY, v3 = -INFINITY; int i1 = 255, i2 = 255, i3 = 255;
        const int nmt = (own + 31) >> 5;
        for (int mt = 0; mt < nmt; ++mt) {
            f32x16 acc;
#pragma unroll
            for (int i = 0; i < 16; ++i) acc[i] = 0.f;
#pragma unroll
            for (int c = 0; c < 4; ++c) {
                const float* kp = KM + ((size_t)bh * 64 + 32 * mt + r32) * 64 + 16 * c + 8 * hi;
                const f32x4 x0 = *(const f32x4*)kp, x1 = *(const f32x4*)(kp + 4);
                u32x4 wh, wl;
                wh.x = pk_bf16(x0[0], x0[1]); wh.y = pk_bf16(x0[2], x0[3]); wh.z = pk_bf16(x1[0], x1[1]); wh.w = pk_bf16(x1[2], x1[3]);
                wl.x = pk_bf16(x0[0] - bf_lo(wh.x), x0[1] - bf_hi(wh.x)); wl.y = pk_bf16(x0[2] - bf_lo(wh.y), x0[3] - bf_hi(wh.y));
                wl.z = pk_bf16(x1[0] - bf_lo(wh.z), x1[1] - bf_hi(wh.z)); wl.w = pk_bf16(x1[2] - bf_lo(wh.w), x1[3] - bf_hi(wh.w));
                acc = mfma32(__builtin_bit_cast(bf16x8, wh), qf[c], acc);
                acc = mfma32(__builtin_bit_cast(bf16x8, wl), qf[c], acc);
            }
#pragma unroll
            for (int i = 0; i < 16; ++i) { const int blk = 32 * mt + crow(i, hi); const bool ok = blk < own; top3_insert(ok ? acc[i] : -INFINITY, ok ? blk : 255, v1, i1, v2, i2, v3, i3); }
        }
        const float ov1 = xhalf(v1), ov2 = xhalf(v2), ov3 = xhalf(v3);
        const int oi1 = __shfl_xor(i1, 32), oi2 = __shfl_xor(i2, 32), oi3 = __shfl_xor(i3, 32);
        top3_insert(ov1, oi1, v1, i1, v2, i2, v3, i3);
        top3_insert(ov2, oi2, v1, i1, v2, i2, v3, i3);
        top3_insert(ov3, oi3, v1, i1, v2, i2, v3, i3);
        if (hi == 0) SEL[srow] = (unsigned)i1 | ((unsigned)i2 << 8) | ((unsigned)i3 << 16) | 0xff000000u;
    }
}
constexpr int MB_K = 0, MB_V = 36864, MB_LIST = 69632, MB_MISC = 102400;
DI void moba_tile(const unsigned char* lds, LAS unsigned char* lds3, const bf16x8 (&qf)[4], int nsub, int diag_sub, int lane, f32x16 (&o)[2], float& m, float& l) {
    const int r32 = lane & 31, hi = lane >> 5;
    const int vlane = (4 * hi + ((lane & 15) >> 2)) * 64 + ((lane >> 4) & 1) * 32 + (lane & 3) * 8;
    for (int kk = 0; kk < nsub; ++kk) {
        bf16x8 kf[4], vf[4];
#pragma unroll
        for (int c = 0; c < 4; ++c) kf[c] = *(const bf16x8*)(lds + MB_K + (32 * kk + r32) * 144 + (16 * c + 8 * hi) * 2);
#pragma unroll
        for (int dt = 0; dt < 2; ++dt) { LAS unsigned char* vb = lds3 + MB_V + dt * 16384 + (32 * kk) * 64 + vlane; vf[2 * dt] = vfrag(vb); vf[2 * dt + 1] = vfrag(vb + 1024); }
        f32x16 s;
#pragma unroll
        for (int i = 0; i < 16; ++i) s[i] = 0.f;
#pragma unroll
        for (int c = 0; c < 4; ++c) s = mfma32(kf[c], qf[c], s);
        if (kk == diag_sub) {
            const int dq = r32 - 4 * hi;
#pragma unroll
            for (int i = 0; i < 16; ++i) s[i] = (((i & 3) + 8 * (i >> 2)) > dq) ? -INFINITY : s[i];
        }
        float mx = fmaxf(fmaxf(s[0], s[1]), s[2]);
#pragma unroll
        for (int i = 3; i < 15; i += 2) mx = fmaxf(fmaxf(mx, s[i]), s[i + 1]);
        mx = fmaxf(mx, s[15]);
        mx = fmaxf(mx, xhalf(mx)) * SCL2;
        const bool trig = mx > m + 8.f;
        if (__any(trig)) {
            const float mn = trig ? mx : m, al = fexp2(m - mn); l *= al; m = mn;
#pragma unroll
            for (int dt = 0; dt < 2; ++dt)
#pragma unroll
                for (int i = 0; i < 16; ++i) o[dt][i] *= al;
        }
        float sum = 0.f;
#pragma unroll
        for (int i = 0; i < 16; ++i) { s[i] = fexp2(__builtin_fmaf(s[i], SCL2, -m)); sum += s[i]; }
        l += sum;
        const bf16x8 p0 = packP<0>(s), p1 = packP<1>(s);
#pragma unroll
        for (int dt = 0; dt < 2; ++dt) { o[dt] = mfma32(vf[2 * dt], p0, o[dt]); o[dt] = mfma32(vf[2 * dt + 1], p1, o[dt]); }
    }
}
DI void moba_stage_kv(const bf16_t* QKV, unsigned char* lds, int b, int h, int blk, int tid) {
    const bf16_t* kb = QKV + ((size_t)b * SEQ + blk * 256) * QKVW + 1024 + h * 64;
    const bf16_t* vb = QKV + ((size_t)b * SEQ + blk * 256) * QKVW + 2048 + h * 64;
    u32x4 kr[4], vr[4];
#pragma unroll
    for (int i = 0; i < 4; ++i) { const int id = tid + 512 * i, key = id >> 3, ch = id & 7; kr[i] = *(const u32x4*)(kb + (size_t)key * QKVW + ch * 8); vr[i] = *(const u32x4*)(vb + (size_t)key * QKVW + ch * 8); }
#pragma unroll
    for (int i = 0; i < 4; ++i) { const int id = tid + 512 * i, key = id >> 3, ch = id & 7; *(u32x4*)(lds + MB_K + key * 144 + ch * 16) = kr[i]; *(u32x4*)(lds + MB_V + (ch >> 2) * 16384 + key * 64 + (ch & 3) * 16) = vr[i]; }
}
DI void phase_moba_sel(const Args& A, unsigned char* lds, LAS unsigned char* lds3, int tid, int wid, int lane) {
    const bf16_t* QKV = (const bf16_t*)(A.ws + WS_QKV); const unsigned* SEL = (const unsigned*)(A.ws + WS_SEL);
    bf16_t* PO = (bf16_t*)(A.ws + WS_PO); float* PML = (float*)(A.ws + WS_PML);
    unsigned* ctr = (unsigned*)(A.ws + WS_CTL) + 64;
    volatile int* misc = (volatile int*)(lds + MB_MISC);
    unsigned short* list = (unsigned short*)(lds + MB_LIST);
    const int r32 = lane & 31, hi = lane >> 5;
    for (;;) {
        __syncthreads();
        if (tid == 0) { misc[0] = (int)atomicAdd(ctr, 1u); misc[1] = 0; }
        __syncthreads();
        const int u = misc[0];
        if (u >= 63 * 32) break;
        const int j = u >> 5, bh = u & 31, b = bh >> 4, h = bh & 15;
        moba_stage_kv(QKV, lds, b, h, j, tid);
        const unsigned* selp = SEL + (size_t)bh * SEQ;
        for (int s0 = (j + 1) * 256 + tid; s0 < SEQ; s0 += 8 * NTHR) {
            unsigned wv[8];
#pragma unroll
            for (int k = 0; k < 8; ++k) { const int s = s0 + k * NTHR; wv[k] = (s < SEQ) ? selp[s] : 0xffffffffu; }
#pragma unroll
            for (int k = 0; k < 8; ++k) {
                const int s = s0 + k * NTHR; const unsigned w = wv[k];
                int slot = -1;
                if ((int)(w & 255u) == j) slot = 0; else if ((int)((w >> 8) & 255u) == j) slot = 1; else if ((int)((w >> 16) & 255u) == j) slot = 2;
                if (slot >= 0) { const int pos = atomicAdd((int*)&misc[1], 1); list[pos] = (unsigned short)((s << 2) | slot); }
            }
        }
        __syncthreads();
        const int cnt = misc[1];
        const int ntile = (cnt + 31) >> 5;
        for (int tl = wid; tl < ntile; tl += NWAVES) {
            const int e = tl * 32 + r32; const bool valid = e < cnt;
            const int ent = list[valid ? e : 0];
            const int s = ent >> 2, slot = ent & 3;
            bf16x8 qf[4];
#pragma unroll
            for (int c = 0; c < 4; ++c) qf[c] = *(const bf16x8*)(QKV + ((size_t)b * SEQ + s) * QKVW + h * 64 + 16 * c + 8 * hi);
            f32x16 o[2];
#pragma unroll
            for (int i = 0; i < 16; ++i) { o[0][i] = 0.f; o[1][i] = 0.f; }
            float m = -INFINITY, l = 0.f;
            moba_tile(lds, lds3, qf, 8, -1, lane, o, m, l);
            const float lt = l + xhalf(l), inv = 1.f / lt;
            if (valid) {
                const size_t pe = ((size_t)bh * SEQ + s) * 3 + slot;
                bf16_t* op = PO + pe * 64;
#pragma unroll
                for (int dt = 0; dt < 2; ++dt)
#pragma unroll
                    for (int gp = 0; gp < 2; ++gp) { u32x4 w; w.x = pk_bf16(o[dt][8 * gp] * inv, o[dt][8 * gp + 1] * inv); w.y = pk_bf16(o[dt][8 * gp + 2] * inv, o[dt][8 * gp + 3] * inv); w.z = pk_bf16(o[dt][8 * gp + 4] * inv, o[dt][8 * gp + 5] * inv); w.w = pk_bf16(o[dt][8 * gp + 6] * inv, o[dt][8 * gp + 7] * inv); *(u32x4*)(op + hi * 32 + dt * 16 + gp * 8) = w; }
                if (hi == 0) { typedef float f32x2_t __attribute__((ext_vector_type(2))); *(f32x2_t*)(PML + pe * 2) = (f32x2_t){m, lt}; }
            }
        }
    }
}
constexpr int MB_GRP = 69632;
DI void moba_stage_kv256(const bf16_t* QKV, unsigned char* ldsg, int b, int h, int blk, int ltid) {
    const bf16_t* kb = QKV + ((size_t)b * SEQ + blk * 256) * QKVW + 1024 + h * 64;
    const bf16_t* vb = QKV + ((size_t)b * SEQ + blk * 256) * QKVW + 2048 + h * 64;
    u32x4 r[8];
#pragma unroll
    for (int i = 0; i < 8; ++i) { const int id = ltid + 256 * i, key = id >> 3, ch = id & 7; r[i] = *(const u32x4*)(kb + (size_t)key * QKVW + ch * 8); }
#pragma unroll
    for (int i = 0; i < 8; ++i) { const int id = ltid + 256 * i, key = id >> 3, ch = id & 7; *(u32x4*)(ldsg + MB_K + key * 144 + ch * 16) = r[i]; }
#pragma unroll
    for (int i = 0; i < 8; ++i) { const int id = ltid + 256 * i, key = id >> 3, ch = id & 7; r[i] = *(const u32x4*)(vb + (size_t)key * QKVW + ch * 8); }
#pragma unroll
    for (int i = 0; i < 8; ++i) { const int id = ltid + 256 * i, key = id >> 3, ch = id & 7; *(u32x4*)(ldsg + MB_V + (ch >> 2) * 16384 + key * 64 + (ch & 3) * 16) = r[i]; }
}
DI void phase_moba_own(const Args& A, unsigned char* lds, LAS unsigned char* lds3, int tid, int wid, int lane) {
    const bf16_t* QKV = (const bf16_t*)(A.ws + WS_QKV); const unsigned* SEL = (const unsigned*)(A.ws + WS_SEL);
    const bf16_t* PO = (const bf16_t*)(A.ws + WS_PO); const float* PML = (const float*)(A.ws + WS_PML); bf16_t* ATT = (bf16_t*)(A.ws + WS_ATT);
    const int r32 = lane & 31, hi = lane >> 5, grp = wid >> 2, g4 = wid & 3;
    unsigned char* ldsg = lds + grp * MB_GRP; LAS unsigned char* lds3g = lds3 + grp * MB_GRP;
    for (int u0 = 2 * blockIdx.x; u0 < BATCH * 16 * 64; u0 += 2 * gridDim.x) {
        const int u = u0 + grp, i = u & 63, bh = u >> 6, b = bh >> 4, h = bh & 15;
        __syncthreads();
        moba_stage_kv256(QKV, ldsg, b, h, i, tid & 255);
        __syncthreads();
#pragma unroll 1
        for (int pass = 0; pass < 2; ++pass) {
            const int tile = pass == 0 ? g4 : 7 - g4;
            const int s = i * 256 + tile * 32 + r32;
            bf16x8 qf[4];
#pragma unroll
            for (int c = 0; c < 4; ++c) qf[c] = *(const bf16x8*)(QKV + ((size_t)b * SEQ + s) * QKVW + h * 64 + 16 * c + 8 * hi);
            f32x16 o[2];
#pragma unroll
            for (int k = 0; k < 16; ++k) { o[0][k] = 0.f; o[1][k] = 0.f; }
            float m = -INFINITY, l = 0.f;
            const unsigned w = SEL[(size_t)bh * SEQ + s];
            const size_t pe0 = ((size_t)bh * SEQ + s) * 3;
            float pm[3], pl[3]; u32x2 pw[3][8];
#pragma unroll
            for (int slot = 0; slot < 3; ++slot) {
                { typedef float f32x2_t __attribute__((ext_vector_type(2))); const f32x2_t ml = *(const f32x2_t*)(PML + (pe0 + slot) * 2); pm[slot] = ml.x; pl[slot] = ml.y; }
#pragma unroll
                for (int dt = 0; dt < 2; ++dt)
#pragma unroll
                    for (int gp = 0; gp < 2; ++gp) { const u32x4 q4 = *(const u32x4*)(PO + (pe0 + slot) * 64 + hi * 32 + dt * 16 + gp * 8); pw[slot][dt * 4 + 2 * gp] = (u32x2){q4.x, q4.y}; pw[slot][dt * 4 + 2 * gp + 1] = (u32x2){q4.z, q4.w}; }
            }
            moba_tile(ldsg, lds3g, qf, tile + 1, tile, lane, o, m, l);
            l += xhalf(l);
#pragma unroll
            for (int slot = 0; slot < 3; ++slot) {
                const int idx = (int)((w >> (8 * slot)) & 255u);
                if (idx != 255) {
                    const float mp = pm[slot], lp = pl[slot];
                    const float M = fmaxf(m, mp), a = fexp2(m - M), bq = fexp2(mp - M) * lp;
#pragma unroll
                    for (int dt = 0; dt < 2; ++dt)
#pragma unroll
                        for (int g = 0; g < 4; ++g) {
                            const u32x2 q2 = pw[slot][dt * 4 + g];
                            o[dt][4 * g] = o[dt][4 * g] * a + bf_lo(q2.x) * bq; o[dt][4 * g + 1] = o[dt][4 * g + 1] * a + bf_hi(q2.x) * bq;
                            o[dt][4 * g + 2] = o[dt][4 * g + 2] * a + bf_lo(q2.y) * bq; o[dt][4 * g + 3] = o[dt][4 * g + 3] * a + bf_hi(q2.y) * bq;
                        }
                    l = l * a + bq; m = M;
                }
            }
            const float inv = 1.f / l;
            bf16_t* op = ATT + ((size_t)b * SEQ + s) * DM + h * 64;
#pragma unroll
            for (int dt = 0; dt < 2; ++dt)
#pragma unroll
                for (int gp = 0; gp < 2; ++gp) {
                    const int g0 = 2 * gp, g1 = 2 * gp + 1;
                    const unsigned x0 = pk_bf16(o[dt][4 * g0] * inv, o[dt][4 * g0 + 1] * inv), x1 = pk_bf16(o[dt][4 * g0 + 2] * inv, o[dt][4 * g0 + 3] * inv);
                    const unsigned y0 = pk_bf16(o[dt][4 * g1] * inv, o[dt][4 * g1 + 1] * inv), y1 = pk_bf16(o[dt][4 * g1 + 2] * inv, o[dt][4 * g1 + 3] * inv);
                    const auto r0 = __builtin_amdgcn_permlane32_swap(x0, y0, false, false), r1 = __builtin_amdgcn_permlane32_swap(x1, y1, false, false);
                    const u32x4 st = {r0[0], r1[0], r0[1], r1[1]};
                    *(u32x4*)(op + 32 * dt + 8 * (hi ? g1 : g0)) = st;
                }
        }
    }
}


#ifndef MK_MULTI
#define MK_MULTI 0
#endif
constexpr int NPHASE = 17;


__constant__ float ROPE_INV_FREQ[8] = {1.0f, 0.1939227432012558f, 0.03760603070259094f, 0.007292664609849453f, 0.0014142135623842478f, 0.00027424818836152554f, 5.3182957344688475e-05f, 1.0313385246263351e-05f};

template <class Epi, bool ALIGN = true> DI void run_gemm(unsigned char* lds, const bf16_t* Am, const bf16_t* Bt, int N, int K, const Epi& E) {
    pg8::Gemm g{Am, Bt, NT, N, K}; pg8::StaticOrder S; S.init(NT, N, (int)gridDim.x, (int)blockIdx.x);
    pg8::gemm_phase<Epi, pg8::StaticOrder, ALIGN, true>((PG8_LAS unsigned char*)lds, g, S, E);
}

typedef const __attribute__((address_space(4))) Args* KArgsP;
DI const Args* kargs() {
#if defined(__HIP_DEVICE_COMPILE__)
    KArgsP p = (KArgsP)__builtin_amdgcn_kernarg_segment_ptr(); asm volatile("" : "+s"(p)); return (const Args*)p;
#else
    return nullptr;
#endif
}
DI int otid() { int t = threadIdx.x; asm volatile("" : "+v"(t)); return t; }
#define CTX const Args A = *kargs(); const int tid = otid(), lane = tid & 63, wid = __builtin_amdgcn_readfirstlane(tid >> 6); LAS unsigned char* lds3 = (LAS unsigned char*)lds; \
    const int G = gridDim.x, gw = blockIdx.x * NWAVES + wid, ngw = G * NWAVES; unsigned char* ws = A.ws; float* out = A.out; (void)lane; (void)lds3; (void)gw; (void)ngw; (void)ws; (void)out; (void)G;

#define IN(k) (lo <= (k) && (k) < hi_ph)
#if MK_MULTI
#define SEAM(k) do { } while (0)
#else
#define SEAM(k) do { if (IN(k) && IN((k) + 1)) { if ((k) == 0) cg::this_grid().sync(); else { XcdBarrier xb_; xb_.bar = (unsigned*)(kargs()->ws + WS_CTL + CTL_BAR_OFF); xb_.x = xb_xcc_id(); xb_.st = (volatile LAS unsigned*)xb_st; xcd_barrier(xb_); } } } while (0)
#endif
#define WB(l) (ws + ((l) == 0 ? WS_WL0 : WS_WL1))
#define pU ((bf16_t*)(ws + WS_U))
#define pQKV ((bf16_t*)(ws + WS_QKV))
#define pATT ((bf16_t*)(ws + WS_ATT))
#define pHID ((bf16_t*)(ws + WS_HID))
#define pPP ((bf16_t*)(ws + WS_PP))
#define pROPE ((const float*)(ws + WS_ROPE))
#define pHB2 ((bf16_t*)out)
#define pPA ((float*)(ws + WS_PA))
#define pPB ((float*)(ws + WS_PB))
template <int l> DI void layer_phases(unsigned char* lds, unsigned* xb_st, const int lo, const int hi_ph) {
    int ph = (l == 0) ? 1 : 7;

        if (IN(ph)) { CTX EpiBf16R E{pQKV, QKVW, 0, l == 0 ? 6 : 0, l == 0 ? 10 : 8, pROPE, l == 0 ? pPA : pPB}; run_gemm(lds, l == 0 ? pU : pHB2, (const bf16_t*)(WB(l) + WO_IN), QKVW, DM, E); }
        SEAM(ph); ++ph;
        if (l == 0) {
            if (IN(ph)) { { CTX phase_attn0(A, lds, lds3, tid, wid, lane); } { CTX phase_attn0_sb(A, lds3, wid, lane); }
            }
            SEAM(ph); ++ph;
        } else {
            if (IN(ph)) { CTX phase_kmean(A, gw, ngw, lane); }
            SEAM(ph); ++ph;
            if (IN(ph)) { CTX phase_gate(A, gw, ngw, lane); }
            SEAM(ph); ++ph;
            if (IN(ph)) { CTX phase_moba_sel(A, lds, lds3, tid, wid, lane); }
            SEAM(ph); ++ph;
            if (IN(ph)) { CTX phase_moba_own(A, lds, lds3, tid, wid, lane); }
            SEAM(ph); ++ph;
        }
        if (IN(ph)) { CTX __syncthreads(); if (l == 0) { EpiRes<false> E{A.in[0], pU, pPA, DM}; run_gemm(lds, pATT, (const bf16_t*)(WB(l) + WO_OUT), DM, DM, E); } else { EpiRes<true> E{pHB2, pU, pPA, DM}; run_gemm(lds, pATT, (const bf16_t*)(WB(l) + WO_OUT), DM, DM, E); } }
        SEAM(ph); ++ph;
        if (IN(ph)) { CTX EpiBf16R E{pHID, FF, 2, 0, 0, pROPE, pPA}; run_gemm(lds, pU, (const bf16_t*)(WB(l) + WO_1), FF, DM, E); }
        SEAM(ph); ++ph;
        if (IN(ph)) { CTX EpiRes<true> E{pU, pU, pPA, DM}; run_gemm(lds, pHID, (const bf16_t*)(WB(l) + WO_2), DM, FF, E); }
        SEAM(ph); ++ph;
        if (IN(ph)) {
            { CTX EpiBf16R E{pPP, DM, 0, 0, 0, pROPE, nullptr}; run_gemm(lds, (const bf16_t*)(ws + (l == 0 ? WS_PB0 : WS_PB1)), (const bf16_t*)(WB(l) + WO_P), DM, PLE, E); }
            __threadfence(); __syncthreads();
            { CTX EpiPle E{pU, pPP, pPA, l == 0 ? pHB2 : pATT, pPB, DM}; run_gemm(lds, pU, (const bf16_t*)(WB(l) + WO_G), DM, DM, E); }
        }
        SEAM(ph); ++ph;
        if (l == 1) {
            if (IN(ph)) { CTX for (int m = gw; m < NT; m += ngw) final_row(pATT + (size_t)m * DM, pPB + (size_t)m * 16, A.in[19], out + (size_t)m * DM, lane); }
            ++ph;
        }
    }

__global__ void __launch_bounds__(NTHR, 2) mega_fwd(Args KA) {
    __shared__ __attribute__((aligned(16))) unsigned char lds[139264];
    const int lo = KA.ph_lo, hi_ph = KA.ph_hi;
    __shared__ __attribute__((aligned(16))) unsigned xb_st[4];
#if !MK_MULTI
    if (threadIdx.x < 4) xb_st[threadIdx.x] = 0u;
    __syncthreads();
    (void)xcd_barrier_post((unsigned*)(kargs()->ws + WS_CTL + CTL_BAR_OFF), (volatile LAS unsigned*)xb_st);
#endif
    if (IN(0)) {
        CTX
        float* scr = (float*)(lds + wid * 17408);
#pragma unroll
        for (int l = 0; l < 2; ++l) {
            unsigned char* wb = ws + (l == 0 ? WS_WL0 : WS_WL1);
            const float* srcs[6] = {A.in[l == 0 ? 4 : 11], A.in[l == 0 ? 5 : 12], A.in[14] + (size_t)l * DM * FF, A.in[15] + (size_t)l * FF * DM, A.in[17] + (size_t)l * DM * DM, A.in[18] + (size_t)l * PLE * DM};
            const int Ks[6] = {DM, DM, DM, FF, DM, PLE}, Ns[6] = {QKVW, DM, FF, DM, DM, DM};
            const float* gs[6] = {A.in[3] + l * DM, nullptr, A.in[13] + l * DM, nullptr, A.in[16] + l * DM, nullptr};
            const size_t offs[6] = {WO_IN, WO_OUT, WO_1, WO_2, WO_G, WO_P};
#pragma unroll
            for (int w = 0; w < 6; ++w) {
                const int nitems = (Ks[w] / 64) * (Ns[w] / 64);
                for (int it = gw; it < nitems; it += ngw) transpose_item(srcs[w], gs[w], Ks[w], Ns[w], (bf16_t*)(wb + offs[w]), scr, it, lane);
            }
        }
        {
            float* rope = (float*)(ws + WS_ROPE); const int* pos = (const int*)A.in[2];
            for (int idx = blockIdx.x * NTHR + tid; idx < NT * 8; idx += G * NTHR) {
                const int row = idx >> 3, i = idx & 7;
                const float ang = (float)pos[row] * ROPE_INV_FREQ[i];
                const double rev = (double)ang * 0.15915494309189535; const float fr = (float)(rev - rint(rev));
                rope[(size_t)row * 16 + i] = __builtin_amdgcn_cosf(fr); rope[(size_t)row * 16 + 8 + i] = __builtin_amdgcn_sinf(fr);
            }
        }
        {
            const float* p = A.in[1];
            constexpr int NG = 2 * NT * PLE / 8, HALF = NT * PLE / 8;
            for (int idx0 = blockIdx.x * NTHR + tid; idx0 < NG; idx0 += 4 * G * NTHR) {
                f32x4 a[4], b[4];
#pragma unroll
                for (int k = 0; k < 4; ++k) { const int idx = idx0 + k * G * NTHR; if (idx < NG) { a[k] = *(const f32x4*)(p + (size_t)idx * 8); b[k] = *(const f32x4*)(p + (size_t)idx * 8 + 4); } }
#pragma unroll
                for (int k = 0; k < 4; ++k) { const int idx = idx0 + k * G * NTHR; if (idx < NG) {
                    const int l = idx / HALF, r = idx % HALF;
                    u32x4 w; w.x = pk_bf16(a[k].x, a[k].y); w.y = pk_bf16(a[k].z, a[k].w); w.z = pk_bf16(b[k].x, b[k].y); w.w = pk_bf16(b[k].z, b[k].w);
                    *(u32x4*)((bf16_t*)(ws + (l == 0 ? WS_PB0 : WS_PB1)) + (size_t)r * 8) = w; } }
            }
        }
        {
            const float* x = A.in[0]; bf16_t* hb = (bf16_t*)(ws + WS_U); float* pa = (float*)(ws + WS_PA);
            for (int m = gw; m < NT; m += 2 * ngw) {
                const int m2 = m + ngw;
                const f32x4* xr = (const f32x4*)(x + (size_t)m * DM) + lane; const f32x4* xr2 = (const f32x4*)(x + (size_t)(m2 < NT ? m2 : m) * DM) + lane;
                f32x4 v[4], v2[4];
#pragma unroll
                for (int j = 0; j < 4; ++j) { v[j] = xr[64 * j]; v2[j] = xr2[64 * j]; }
                float s = 0.f, s2 = 0.f;
#pragma unroll
                for (int j = 0; j < 4; ++j) { s += (v[j].x * v[j].x + v[j].y * v[j].y) + (v[j].z * v[j].z + v[j].w * v[j].w); s2 += (v2[j].x * v2[j].x + v2[j].y * v2[j].y) + (v2[j].z * v2[j].z + v2[j].w * v2[j].w); }
                s = wave_sum(s); s2 = wave_sum(s2);
                u32x2* o8 = (u32x2*)(hb + (size_t)m * DM) + lane;
#pragma unroll
                for (int j = 0; j < 4; ++j) { u32x2 w; w.x = pk_bf16(v[j].x, v[j].y); w.y = pk_bf16(v[j].z, v[j].w); o8[64 * j] = w; }
                if (lane < 16) pa[(size_t)m * 16 + lane] = (lane == 0) ? s : 0.f;
                if (m2 < NT) {
                    u32x2* o82 = (u32x2*)(hb + (size_t)m2 * DM) + lane;
#pragma unroll
                    for (int j = 0; j < 4; ++j) { u32x2 w; w.x = pk_bf16(v2[j].x, v2[j].y); w.y = pk_bf16(v2[j].z, v2[j].w); o82[64 * j] = w; }
                    if (lane < 16) pa[(size_t)m2 * 16 + lane] = (lane == 0) ? s2 : 0.f;
                }
            }
        }
    }
    SEAM(0);
    layer_phases<0>(lds, xb_st, lo, hi_ph);
    layer_phases<1>(lds, xb_st, lo, hi_ph);
#undef IN
#undef SEAM
}

extern "C" void kernel_launch(void* const* d_in, const int* in_sizes, int n_in, void* d_out, int out_size, void* d_ws, size_t ws_size, hipStream_t stream) {
    static int grid = 0;
    if (grid == 0) {
        if (n_in != 20 || out_size != NT * DM || ws_size < WS_END) { fprintf(stderr, "kernel_launch: unexpected shapes (n_in %d, out %d, ws %zu < %zu); nothing launched\n", n_in, out_size, ws_size, (size_t)WS_END); grid = -1; return; }
        int dev = 0, cus = 0, per_cu = 0;
        hipGetDevice(&dev);
        hipDeviceGetAttribute(&cus, hipDeviceAttributeMultiprocessorCount, dev);
        hipOccupancyMaxActiveBlocksPerMultiprocessor(&per_cu, (const void*)mega_fwd, NTHR, 0);
        if (per_cu < 1) { fprintf(stderr, "kernel_launch: occupancy query says %d blocks per CU\n", per_cu); per_cu = 1; }
        grid = cus;
        (void)hipGetLastError();
    }
    if (grid < 0) return;
    hipMemsetAsync((char*)d_ws + WS_CTL, 0, CTL_BYTES, stream);
    Args a{};
    for (int i = 0; i < 20; ++i) a.in[i] = (const float*)d_in[i];
    a.out = (float*)d_out; a.ws = (unsigned char*)d_ws;
#if MK_MULTI
    for (int p = 0; p < NPHASE; ++p) { a.ph_lo = p; a.ph_hi = p + 1; hipLaunchKernelGGL(mega_fwd, dim3(grid), dim3(NTHR), 0, stream, a); }
#else
    a.ph_lo = 0; a.ph_hi = NPHASE;
    void* args[] = {&a};
    hipError_t e = hipLaunchCooperativeKernel((const void*)mega_fwd, dim3(grid), dim3(NTHR), args, 0, stream);
    if (e != hipSuccess) fprintf(stderr, "kernel_launch: cooperative launch failed: %s (grid %d)\n", hipGetErrorString(e), grid);
#endif
}
```

```cpp
#include <hip/hip_runtime.h>
#include <hip/hip_cooperative_groups.h>
#include <cstdio>
#include <cstdint>
namespace cg = cooperative_groups;
namespace pg8 {
#define PG8_LAS __attribute__((address_space(3)))
typedef unsigned short bf16_t;
typedef short bf16x8 __attribute__((ext_vector_type(8)));
typedef float f32x4 __attribute__((ext_vector_type(4)));
typedef unsigned u32x4 __attribute__((ext_vector_type(4)));
constexpr int BM = 256, BK = 64, HALF = 128, HTB = HALF * BK * 2  , STAGE_BYTES = 8 * HTB, NXCD = 8, WGM = 8;

__host__ __device__ __forceinline__ int lds_byte(int r, int c) { const int st = (r >> 4) * 2 + (c >> 5), rr = r & 15, cc = c & 31, ob = rr * 64 + cc * 2; return st * 1024 + (ob ^ (((ob >> 9) & 1) << 5)); }
__host__ __device__ __forceinline__ void stage_rc(int b, int& R, int& C) { const int st = b / 1024, sb = b % 1024, swz = sb ^ (((sb >> 9) & 1) << 5); R = (st >> 1) * 16 + swz / 64; C = (st & 1) * 32 + (swz % 64) / 2; }
__host__ __device__ __forceinline__ int perm32(int rho) { const int n = rho >> 4, i = rho & 15; return 8 * (i >> 2) + 4 * n + (i & 3); }

struct Unit { int pm, pn; };
struct Gemm { const bf16_t* A; const bf16_t* Bt; int M, N, K; };

struct StaticOrder {
    int nM, nN, nwg, G, c;
    __host__ __device__ void init(int M, int N, int G_, int c_) { nM = M / BM; nN = N / BM; nwg = nM * nN; G = G_; c = c_; }
    __host__ __device__ bool next(int i, Unit& u) const {
        const long L = (long)i * G + c; if (L >= nwg) return false;
        int wgid = (int)L; { const int q = nwg / NXCD, r = nwg % NXCD, xcd = wgid % NXCD, off = wgid / NXCD; wgid = (xcd < r ? xcd * (q + 1) : r * (q + 1) + (xcd - r) * q) + off; }
        const int nig = WGM * nN, gid = wgid / nig, fm = gid * WGM, gsz = (nM - fm) < WGM ? (nM - fm) : WGM;
        u.pm = fm + ((wgid % nig) % gsz); u.pn = (wgid % nig) / gsz; return true;
    }
    __device__ __forceinline__ void a_ready(const Unit&) const {}
    __device__ __forceinline__ void done(const Unit&) const {}
};

__device__ __forceinline__ unsigned cvt_pk_bf16(float lo, float hi) { unsigned r; asm volatile("v_cvt_pk_bf16_f32 %0, %1, %2" : "=v"(r) : "v"(lo), "v"(hi)); return r; }
typedef float f32x2 __attribute__((ext_vector_type(2)));
template <class Epi, class Sched, bool ALIGN_EPI = false, bool SP2 = false>
__device__ __forceinline__ void gemm_phase(PG8_LAS unsigned char* lds, const Gemm g, const Sched& S, const Epi& E) {
    int tid_ = threadIdx.x; asm volatile("" : "+v"(tid_)); const int tid = tid_, wid = __builtin_amdgcn_readfirstlane(tid >> 6), lane = tid & 63, wr = wid >> 2, wc = wid & 3, fr = lane & 15, fq = lane >> 4;
    const int K = g.K, nt = K / BK;
    unsigned voffA[2], voffB[2];
#pragma unroll
    for (int i = 0; i < 2; ++i) { int R, C; stage_rc(tid * 16 + i * 8192, R, C); const int Rb = Epi::PERM ? ((R & ~31) + perm32(R & 31)) : R;
        voffA[i] = (unsigned)(R * K + C) * 2u; voffB[i] = (unsigned)(Rb * K + C) * 2u; }
    const size_t kstep = (size_t)(BK * 2);
    const size_t hstep = (size_t)HALF * K * 2;
    const size_t tstep = 2 * hstep;
    const unsigned ldsw = (unsigned)wid * 1024u;
    const int aoff = lds_byte(wr * 64 + fr, fq * 8), boff = lds_byte(wc * 32 + fr, fq * 8);
#define PG8_SA(b, h) (((b) * 2 + (h)) * HTB)
#define PG8_SB(b, h) ((4 + (b) * 2 + (h)) * HTB)
#define PG8_STAGE(bufoff, gbase, voff) do { _Pragma("unroll") for (int _i = 0; _i < 2; ++_i) \
        __builtin_amdgcn_global_load_lds((const unsigned*)((const char*)(gbase) + (voff)[_i]), (PG8_LAS unsigned*)(lds + (bufoff) + ldsw + _i * 8192), 16, 0, 0); } while (0)
#define PG8_LDA(dst, b, h) do { _Pragma("unroll") for (int m = 0; m < 4; ++m) _Pragma("unroll") for (int k = 0; k < 2; ++k) dst[m][k] = *(const PG8_LAS bf16x8*)(lds + PG8_SA(b, h) + aoff + m * 2048 + k * 1024); } while (0)
#define PG8_LDB(dst, b, h) do { _Pragma("unroll") for (int n = 0; n < 2; ++n) _Pragma("unroll") for (int k = 0; k < 2; ++k) dst[n][k] = *(const PG8_LAS bf16x8*)(lds + PG8_SB(b, h) + boff + n * 2048 + k * 1024); } while (0)
#define PG8_MMA(ai, bj, At, Bt) do { __builtin_amdgcn_s_setprio(1); _Pragma("unroll") for (int m = 0; m < 4; ++m) _Pragma("unroll") for (int n = 0; n < 2; ++n) _Pragma("unroll") for (int k = 0; k < 2; ++k) \
        acc[ai][bj][m][n] = __builtin_amdgcn_mfma_f32_16x16x32_bf16(Bt[n][k], At[m][k], acc[ai][bj][m][n], 0, 0, 0); __builtin_amdgcn_s_setprio(0); } while (0)
#define PG8_WAIT_V(n) asm volatile("s_waitcnt vmcnt(" #n ")" ::: "memory")
#define PG8_WAIT_L(n) asm volatile("s_waitcnt lgkmcnt(" #n ")" ::: "memory")
#define PG8_BAR __builtin_amdgcn_s_barrier()
#define PG8_SCHED __builtin_amdgcn_sched_barrier(0)
    Unit cur, nxt; int ui = 0;
    if (!S.next(0, cur)) return;
    f32x4 acc[2][2][4][2];
#pragma unroll
    for (int a = 0; a < 2; ++a)
#pragma unroll
        for (int b = 0; b < 2; ++b)
#pragma unroll
            for (int m = 0; m < 4; ++m)
#pragma unroll
                for (int n = 0; n < 2; ++n) acc[a][b][m][n] = (f32x4){0.f, 0.f, 0.f, 0.f};
    bf16x8 At[4][2], B0[2][2], B1[2][2];
    const char* cA = (const char*)g.A + (size_t)cur.pm * tstep; const char* cB = (const char*)g.Bt + (size_t)cur.pn * tstep;
    S.a_ready(cur);
    if constexpr (SP2) {
        PG8_STAGE(PG8_SB(0, 0), cB, voffB); PG8_STAGE(PG8_SB(0, 1), cB + hstep, voffB); PG8_STAGE(PG8_SA(0, 0), cA, voffA); PG8_STAGE(PG8_SA(0, 1), cA + hstep, voffA);
        if (wr == 1) PG8_BAR;
        PG8_WAIT_V(2); PG8_BAR;
        PG8_STAGE(PG8_SB(1, 0), cB + kstep, voffB); PG8_STAGE(PG8_SA(1, 0), cA + kstep, voffA); PG8_STAGE(PG8_SB(1, 1), cB + hstep + kstep, voffB);
        PG8_WAIT_V(6); PG8_BAR;
    } else {
        PG8_STAGE(PG8_SB(0, 0), cB, voffB); PG8_STAGE(PG8_SA(0, 0), cA, voffA); PG8_STAGE(PG8_SB(0, 1), cB + hstep, voffB); PG8_STAGE(PG8_SA(0, 1), cA + hstep, voffA);
        if (wr == 1) PG8_BAR;
        PG8_WAIT_V(4); PG8_BAR;
        PG8_STAGE(PG8_SB(1, 0), cB + kstep, voffB); PG8_STAGE(PG8_SA(1, 0), cA + kstep, voffA); PG8_STAGE(PG8_SB(1, 1), cB + hstep + kstep, voffB);
        PG8_WAIT_V(6); PG8_BAR;
    }
    for (;;) {
        const bool has_next = S.next(ui + 1, nxt);
        const char* nA = has_next ? (const char*)g.A + (size_t)nxt.pm * tstep : cA; const char* nB = has_next ? (const char*)g.Bt + (size_t)nxt.pn * tstep : cB;
        for (int t = 0; t < nt; t += 2) {
            const bool last = (t == nt - 2);
            const char* a1 = cA + (size_t)(t + 1) * kstep;
            const char* a2 = last ? nA : cA + (size_t)(t + 2) * kstep; const char* b2 = last ? nB : cB + (size_t)(t + 2) * kstep;
            const char* a3 = a2 + kstep; const char* b3 = b2 + kstep;
            if (last && has_next) S.a_ready(nxt);
            if constexpr (SP2) {
            PG8_LDB(B0, 0, 0); PG8_LDB(B1, 0, 1); PG8_SCHED; PG8_LDA(At, 0, 0); PG8_STAGE(PG8_SA(1, 1), a1 + hstep, voffA);
            PG8_WAIT_V(8); PG8_WAIT_L(0); PG8_BAR; PG8_MMA(0, 0, At, B0); PG8_MMA(0, 1, At, B1); PG8_BAR; PG8_SCHED;
            PG8_LDA(At, 0, 1); PG8_STAGE(PG8_SB(0, 0), b2, voffB); PG8_STAGE(PG8_SB(0, 1), b2 + hstep, voffB); PG8_STAGE(PG8_SA(0, 0), a2, voffA);
            PG8_WAIT_V(8); PG8_WAIT_L(0); PG8_BAR; PG8_MMA(1, 0, At, B0); PG8_MMA(1, 1, At, B1); PG8_BAR; PG8_SCHED;
            PG8_LDB(B0, 1, 0); PG8_LDB(B1, 1, 1); PG8_SCHED; PG8_LDA(At, 1, 0); PG8_STAGE(PG8_SA(0, 1), a2 + hstep, voffA);
            PG8_WAIT_V(8); PG8_WAIT_L(0); PG8_BAR; PG8_MMA(0, 0, At, B0); PG8_MMA(0, 1, At, B1); PG8_BAR; PG8_SCHED;
            PG8_LDA(At, 1, 1); PG8_STAGE(PG8_SB(1, 0), b3, voffB); PG8_STAGE(PG8_SB(1, 1), b3 + hstep, voffB); PG8_STAGE(PG8_SA(1, 0), a3, voffA);
            PG8_WAIT_V(8); PG8_WAIT_L(0); PG8_BAR; PG8_MMA(1, 0, At, B0); PG8_MMA(1, 1, At, B1); PG8_BAR; PG8_SCHED;
            } else {
            PG8_LDB(B0, 0, 0); PG8_SCHED; PG8_LDA(At, 0, 0); PG8_STAGE(PG8_SA(1, 1), a1 + hstep, voffA);
            PG8_WAIT_L(8); PG8_BAR; PG8_WAIT_L(0); PG8_MMA(0, 0, At, B0); PG8_BAR; PG8_SCHED;
            PG8_LDB(B1, 0, 1); PG8_STAGE(PG8_SB(0, 0), b2, voffB);
            PG8_BAR; PG8_WAIT_L(0); PG8_MMA(0, 1, At, B1); PG8_BAR;
            PG8_LDA(At, 0, 1); PG8_STAGE(PG8_SA(0, 0), a2, voffA);
            PG8_BAR; PG8_WAIT_L(0); PG8_MMA(1, 0, At, B0); PG8_BAR; PG8_SCHED;
            PG8_STAGE(PG8_SB(0, 1), b2 + hstep, voffB);
            PG8_WAIT_V(6); PG8_BAR; PG8_MMA(1, 1, At, B1); PG8_BAR;
            PG8_LDB(B0, 1, 0); PG8_SCHED; PG8_LDA(At, 1, 0); PG8_STAGE(PG8_SA(0, 1), a2 + hstep, voffA);
            PG8_WAIT_L(8); PG8_BAR; PG8_WAIT_L(0); PG8_MMA(0, 0, At, B0); PG8_BAR; PG8_SCHED;
            PG8_LDB(B1, 1, 1); PG8_STAGE(PG8_SB(1, 0), b3, voffB);
            PG8_BAR; PG8_WAIT_L(0); PG8_MMA(0, 1, At, B1); PG8_BAR;
            PG8_LDA(At, 1, 1); PG8_STAGE(PG8_SA(1, 0), a3, voffA);
            PG8_BAR; PG8_WAIT_L(0); PG8_MMA(1, 0, At, B0); PG8_BAR; PG8_SCHED;
            PG8_STAGE(PG8_SB(1, 1), b3 + hstep, voffB);
            PG8_WAIT_V(6); PG8_BAR; PG8_MMA(1, 1, At, B1); PG8_BAR;
            }
        }
        if constexpr (ALIGN_EPI) { if (wr == 0) PG8_BAR; }
        if constexpr (!Epi::AFTER_DRAIN) { E(acc, cur, wr, wc, fr, fq); S.done(cur); }
        if (!has_next) break;
#pragma unroll
        for (int a = 0; a < 2; ++a)
#pragma unroll
            for (int b = 0; b < 2; ++b)
#pragma unroll
                for (int m = 0; m < 4; ++m)
#pragma unroll
                    for (int n = 0; n < 2; ++n) acc[a][b][m][n] = (f32x4){0.f, 0.f, 0.f, 0.f};
        cur = nxt; cA = nA; cB = nB; ++ui;
        if constexpr (ALIGN_EPI) { if (wr == 1) PG8_BAR; }
    }
    PG8_WAIT_V(0);
    if constexpr (!ALIGN_EPI) { if (wr == 0) PG8_BAR; }
    PG8_BAR;
    if constexpr (Epi::AFTER_DRAIN) { E.fused(acc, cur, wr, wc, fr, fq, lds, wid, lane); S.done(cur); }
#undef PG8_SA
#undef PG8_SB
#undef PG8_STAGE
#undef PG8_LDA
#undef PG8_LDB
#undef PG8_MMA
#undef PG8_WAIT_V
#undef PG8_WAIT_L
#undef PG8_BAR
#undef PG8_SCHED
}
}

#define DI __device__ __forceinline__
#define LAS __attribute__((address_space(3)))
typedef unsigned short bf16_t;
typedef short bf16x8 __attribute__((ext_vector_type(8)));
typedef short s16x4 __attribute__((ext_vector_type(4)));
typedef short v4i16_t __attribute__((ext_vector_type(4)));
typedef float f32x4 __attribute__((ext_vector_type(4)));
typedef float f32x16 __attribute__((ext_vector_type(16)));
typedef unsigned u32x4 __attribute__((ext_vector_type(4)));
typedef unsigned u32x2 __attribute__((ext_vector_type(2)));

constexpr int BATCH = 2, SEQ = 16384, DM = 1024, NT = BATCH * SEQ, FF = 4096, PLE = 256, QKVW = 3072;
constexpr int NWAVES = 8, NTHR = 512;
constexpr float NORM_EPS = 1e-6f;
constexpr float LOG2E = 1.4426950408889634f;
constexpr float SCL2 = 0.125f * LOG2E;
constexpr size_t MiB = 1u << 20;
constexpr size_t WS_CTL = 0, CTL_BYTES = 65536, CTL_BAR_OFF = 16384;
constexpr size_t WS_WL1 = 1 * MiB, WS_ROPE = 28 * MiB, WS_PB1 = 30 * MiB, WS_KM = 46 * MiB, WS_SEL = 47 * MiB, WS_PML = 49 * MiB;
constexpr size_t WS_QKV = 64 * MiB, WS_ATT = 256 * MiB, WS_HID = 64 * MiB, WS_PP = 64 * MiB, WS_U = 320 * MiB;
constexpr size_t WS_PA = 61 * MiB, WS_PB = 46 * MiB;
constexpr size_t WS_WL0 = 384 * MiB, WS_PB0 = 412 * MiB, WS_PO = 320 * MiB, WS_END = 512 * MiB;
constexpr size_t WO_IN = 0, WO_OUT = 6 * MiB, WO_1 = 8 * MiB, WO_2 = 16 * MiB, WO_G = 24 * MiB, WO_P = 26 * MiB;

struct Args { const float* in[20]; float* out; unsigned char* ws; int ph_lo, ph_hi; };

DI unsigned pk_bf16(float lo, float hi) { typedef float f2 __attribute__((ext_vector_type(2))); typedef __bf16 b2 __attribute__((ext_vector_type(2))); f2 v = {lo, hi}; b2 b = __builtin_convertvector(v, b2); return __builtin_bit_cast(unsigned, b); }
DI float bf_lo(unsigned w) { return __uint_as_float(w << 16); }
DI float bf_hi(unsigned w) { return __uint_as_float(w & 0xffff0000u); }
DI float xhalf(float v) { return __shfl_xor(v, 32); }
DI int crow(int i, int hi) { return (i & 3) + 8 * (i >> 2) + 4 * hi; }
DI f32x16 mfma32(bf16x8 a, bf16x8 b, f32x16 c) { return __builtin_amdgcn_mfma_f32_32x32x16_bf16(a, b, c, 0, 0, 0); }
DI s16x4 tr_read(LAS unsigned char* p) { return __builtin_bit_cast(s16x4, __builtin_amdgcn_ds_read_tr16_b64_v4i16((LAS v4i16_t*)p)); }
DI bf16x8 vfrag(LAS unsigned char* p) { const s16x4 lo = tr_read(p), hi = tr_read(p + 512); return __builtin_shufflevector(lo, hi, 0, 1, 2, 3, 4, 5, 6, 7); }
DI float fexp2(float x) { return __builtin_amdgcn_exp2f(x); }
template <int S> DI bf16x8 packP(const f32x16& p) {
    u32x4 w; w.x = pk_bf16(p[8 * S + 0], p[8 * S + 1]); w.y = pk_bf16(p[8 * S + 2], p[8 * S + 3]); w.z = pk_bf16(p[8 * S + 4], p[8 * S + 5]); w.w = pk_bf16(p[8 * S + 6], p[8 * S + 7]);
    return __builtin_bit_cast(bf16x8, w);
}
DI float wave_sum(float v) {
#pragma unroll
    for (int o = 1; o < 64; o <<= 1) v += __shfl_xor(v, o);
    return v;
}
template <int NO> DI void softmax_step(f32x16& s, float& m, float& l, f32x16 (&o)[NO]) {
    float mx = s[0];
#pragma unroll
    for (int i = 1; i < 16; ++i) mx = fmaxf(mx, s[i]);
    mx = fmaxf(mx, xhalf(mx));
    const float mn = fmaxf(m, mx);
    if (__any(mn > m)) {
        const float al = fexp2(m - mn); l *= al;
#pragma unroll
        for (int t = 0; t < NO; ++t)
#pragma unroll
            for (int i = 0; i < 16; ++i) o[t][i] *= al;
    }
    m = mn;
    float sum = 0.f;
#pragma unroll
    for (int i = 0; i < 16; ++i) { s[i] = fexp2(s[i] - mn); sum += s[i]; }
    l += sum;
}

struct EpiBf16R {
    static constexpr bool PERM = true, AFTER_DRAIN = false;
    bf16_t* O; int ldc; int act; int rope_lo, rope_hi; const float* rope; const float* part;
    DI void operator()(const f32x4 (&acc)[2][2][4][2], const pg8::Unit& u, int wr, int wc, int fr, int fq) const {
        const int row0 = u.pm * 256 + wr * 64 + fr, col0 = u.pn * 256 + wc * 32 + 8 * fq;
        const bool do_rope = (u.pn >= rope_lo) && (u.pn < rope_hi);
        const bool mine = ((wc & 1) == 0) && (fq < 2);
        const float sgn = (fq == 0) ? -1.f : 1.f;
#pragma unroll
        for (int ai = 0; ai < 2; ++ai)
#pragma unroll
            for (int m = 0; m < 4; ++m) {
                const int row = row0 + ai * 128 + m * 16;
                bf16_t* rowp = O + (size_t)row * ldc + col0;
                float rs = 1.f;
                if (part) { const f32x4* pq = (const f32x4*)(part + (size_t)row * 16); const f32x4 t4 = (pq[0] + pq[1]) + (pq[2] + pq[3]); rs = 1.0f / sqrtf(((t4.x + t4.y) + (t4.z + t4.w)) * (1.f / DM) + NORM_EPS); }
                f32x4 c0 = {1.f, 1.f, 1.f, 1.f}, c1 = c0, s0 = {0.f, 0.f, 0.f, 0.f}, s1 = s0;
                if (do_rope && mine) { const float* cs = rope + (size_t)row * 16; c0 = *(const f32x4*)cs; c1 = *(const f32x4*)(cs + 4); s0 = *(const f32x4*)(cs + 8) * sgn; s1 = *(const f32x4*)(cs + 12) * sgn; }
#pragma unroll
                for (int bj = 0; bj < 2; ++bj) {
                    f32x4 v0 = acc[ai][bj][m][0] * rs, v1 = acc[ai][bj][m][1] * rs;
                    if (act == 2) {
#pragma unroll
                        for (int k = 0; k < 4; ++k) { const float a = fmaxf(v0[k], 0.f), b = fmaxf(v1[k], 0.f); v0[k] = a * a; v1[k] = b * b; }
                    }
                    if (do_rope) {
                        f32x4 p0, p1;
#pragma unroll
                        for (int k = 0; k < 4; ++k) { p0[k] = __shfl_xor(v0[k], 16); p1[k] = __shfl_xor(v1[k], 16); }
                        v0 = v0 * c0 + p0 * s0; v1 = v1 * c1 + p1 * s1;
                    }
                    u32x4 w; w.x = pk_bf16(v0[0], v0[1]); w.y = pk_bf16(v0[2], v0[3]); w.z = pk_bf16(v1[0], v1[1]); w.w = pk_bf16(v1[2], v1[3]);
                    *(u32x4*)(rowp + bj * 128) = w;
                }
            }
    }
};
template <bool BASE_BF16> struct EpiRes {
    static constexpr bool PERM = true, AFTER_DRAIN = false;
    const void* base; bf16_t* hb; float* part; int ldc;
    DI void operator()(const f32x4 (&acc)[2][2][4][2], const pg8::Unit& u, int wr, int wc, int fr, int fq) const {
        const int row0 = u.pm * 256 + wr * 64 + fr, col0 = u.pn * 256 + wc * 32 + 8 * fq;
#pragma unroll
        for (int ai = 0; ai < 2; ++ai)
#pragma unroll
            for (int m = 0; m < 4; ++m) {
                const int row = row0 + ai * 128 + m * 16;
                const size_t off = (size_t)row * ldc + col0;
                float ss = 0.f;
#pragma unroll
                for (int bj = 0; bj < 2; ++bj) {
                    const size_t o2 = off + bj * 128;
                    f32x4 b0, b1v;
                    if (BASE_BF16) { const u32x4 bw = *(const u32x4*)((const bf16_t*)base + o2); b0 = (f32x4){bf_lo(bw.x), bf_hi(bw.x), bf_lo(bw.y), bf_hi(bw.y)}; b1v = (f32x4){bf_lo(bw.z), bf_hi(bw.z), bf_lo(bw.w), bf_hi(bw.w)}; }
                    else { b0 = *(const f32x4*)((const float*)base + o2); b1v = *(const f32x4*)((const float*)base + o2 + 4); }
                    const f32x4 r0 = b0 + acc[ai][bj][m][0], r1 = b1v + acc[ai][bj][m][1];
                    u32x4 w; w.x = pk_bf16(r0[0], r0[1]); w.y = pk_bf16(r0[2], r0[3]); w.z = pk_bf16(r1[0], r1[1]); w.w = pk_bf16(r1[2], r1[3]);
                    *(u32x4*)(hb + o2) = w;
                    ss += ((r0[0] * r0[0] + r0[1] * r0[1]) + (r0[2] * r0[2] + r0[3] * r0[3])) + ((r1[0] * r1[0] + r1[1] * r1[1]) + (r1[2] * r1[2] + r1[3] * r1[3]));
                }
                ss += __shfl_xor(ss, 16); ss += __shfl_xor(ss, 32);
                if (fq == 0) part[(size_t)row * 16 + u.pn * 4 + wc] = ss;
            }
    }
};
struct EpiPle {
    static constexpr bool PERM = true, AFTER_DRAIN = false;
    const bf16_t* base; const bf16_t* pp; const float* partin; bf16_t* hb; float* part; int ldc;
    DI void operator()(const f32x4 (&acc)[2][2][4][2], const pg8::Unit& u, int wr, int wc, int fr, int fq) const {
        const int row0 = u.pm * 256 + wr * 64 + fr, col0 = u.pn * 256 + wc * 32 + 8 * fq;
#pragma unroll
        for (int ai = 0; ai < 2; ++ai)
#pragma unroll
            for (int m = 0; m < 4; ++m) {
                const int row = row0 + ai * 128 + m * 16;
                const size_t off = (size_t)row * ldc + col0;
                const f32x4* pq = (const f32x4*)(partin + (size_t)row * 16); const f32x4 t4 = (pq[0] + pq[1]) + (pq[2] + pq[3]);
                const float rs = -1.0f / sqrtf(((t4.x + t4.y) + (t4.z + t4.w)) * (1.f / DM) + NORM_EPS);
                float ss = 0.f;
#pragma unroll
                for (int bj = 0; bj < 2; ++bj) {
                    const size_t o2 = off + bj * 128;
                    const u32x4 pw = *(const u32x4*)(pp + o2), bw = *(const u32x4*)(base + o2);
                    const f32x4 a0 = acc[ai][bj][m][0] * rs, a1 = acc[ai][bj][m][1] * rs;
                    f32x4 r0, r1;
                    r0[0] = bf_lo(bw.x) + bf_lo(pw.x) / (1.f + __expf(a0[0])); r0[1] = bf_hi(bw.x) + bf_hi(pw.x) / (1.f + __expf(a0[1]));
                    r0[2] = bf_lo(bw.y) + bf_lo(pw.y) / (1.f + __expf(a0[2])); r0[3] = bf_hi(bw.y) + bf_hi(pw.y) / (1.f + __expf(a0[3]));
                    r1[0] = bf_lo(bw.z) + bf_lo(pw.z) / (1.f + __expf(a1[0])); r1[1] = bf_hi(bw.z) + bf_hi(pw.z) / (1.f + __expf(a1[1]));
                    r1[2] = bf_lo(bw.w) + bf_lo(pw.w) / (1.f + __expf(a1[2])); r1[3] = bf_hi(bw.w) + bf_hi(pw.w) / (1.f + __expf(a1[3]));
                    u32x4 w; w.x = pk_bf16(r0[0], r0[1]); w.y = pk_bf16(r0[2], r0[3]); w.z = pk_bf16(r1[0], r1[1]); w.w = pk_bf16(r1[2], r1[3]);
                    *(u32x4*)(hb + o2) = w;
                    ss += ((r0[0] * r0[0] + r0[1] * r0[1]) + (r0[2] * r0[2] + r0[3] * r0[3])) + ((r1[0] * r1[0] + r1[1] * r1[1]) + (r1[2] * r1[2] + r1[3] * r1[3]));
                }
                ss += __shfl_xor(ss, 16); ss += __shfl_xor(ss, 32);
                if (fq == 0) part[(size_t)row * 16 + u.pn * 4 + wc] = ss;
            }
    }
};

DI void final_row(const bf16_t* hrow, const float* prow, const float* g, float* orow, int lane) {
    const float pv = (lane < 16) ? prow[lane] : 0.f;
    const float r = 1.0f / sqrtf(wave_sum(pv) * (1.f / DM) + NORM_EPS);
#pragma unroll
    for (int j = 0; j < 2; ++j) {
        const int c0 = j * 512 + lane * 8;
        const u32x4 w = *(const u32x4*)(hrow + c0);
        const f32x4 g0 = *(const f32x4*)(g + c0), g1 = *(const f32x4*)(g + c0 + 4);
        *(f32x4*)(orow + c0) = (f32x4){bf_lo(w.x) * r * g0.x, bf_hi(w.x) * r * g0.y, bf_lo(w.y) * r * g0.z, bf_hi(w.y) * r * g0.w};
        *(f32x4*)(orow + c0 + 4) = (f32x4){bf_lo(w.z) * r * g1.x, bf_hi(w.z) * r * g1.y, bf_lo(w.w) * r * g1.z, bf_hi(w.w) * r * g1.w};
    }
}
DI void transpose_item(const float* W, const float* g, int K, int N, bf16_t* WT, float* scr, int item, int lane) {
    const int nblk = N / 64, kb = item / nblk, nb = item % nblk, k0 = 64 * kb, n0 = 64 * nb;
    const int lr = lane >> 4, lc = (lane & 15) * 4;
#pragma unroll 8
    for (int i = 0; i < 16; ++i) {
        const int kk = 4 * i + lr; const float gv = g ? g[k0 + kk] : 1.f;
        const f32x4 v = *(const f32x4*)(W + (size_t)(k0 + kk) * N + n0 + lc);
        float* d = scr + kk * 65 + lc; d[0] = v.x * gv; d[1] = v.y * gv; d[2] = v.z * gv; d[3] = v.w * gv;
    }
    asm volatile("s_waitcnt lgkmcnt(0)" ::: "memory");
    const int c = lane & 7;
#pragma unroll
    for (int j = 0; j < 8; ++j) {
        const int n = (lane >> 3) + 8 * j; const float* s = scr + (8 * c) * 65 + n;
        u32x4 o; o.x = pk_bf16(s[0 * 65], s[1 * 65]); o.y = pk_bf16(s[2 * 65], s[3 * 65]); o.z = pk_bf16(s[4 * 65], s[5 * 65]); o.w = pk_bf16(s[6 * 65], s[7 * 65]);
        *(u32x4*)(WT + (size_t)(n0 + n) * K + k0 + 8 * c) = o;
    }
    asm volatile("s_waitcnt lgkmcnt(0)" ::: "memory");
}
#define GAS __attribute__((address_space(1)))
#define RLX_AGENT __ATOMIC_RELAXED, __HIP_MEMORY_SCOPE_AGENT
#define XB_TMO      128
#define XB_XCNT(j)  (256  + 64 * (j))
#define XB_XSUB(j)  (1280 + 64 * (j))
#define XB_XGEN(j)  (2304 + 64 * (j))
#define XB_TOP      3328
#define XB_TOPGEN   3392
#define XCD_BAR_WORDS 3456
#define XB_SPIN_CAP (1u << 18)

__device__ __forceinline__ unsigned xb_ld(unsigned* p)              { return __hip_atomic_load(p, __ATOMIC_RELAXED, __HIP_MEMORY_SCOPE_AGENT); }
__device__ __forceinline__ unsigned xb_add(unsigned* p, unsigned v) { return __hip_atomic_fetch_add(p, v, __ATOMIC_RELAXED, __HIP_MEMORY_SCOPE_AGENT); }
__device__ __forceinline__ unsigned xb_xcc_id() { return (unsigned)__builtin_amdgcn_s_getreg((3 << 11) | 20) & 0xFu; }
#define XB_SPIN(cond, bar) do { unsigned _sp = 0; while (cond) { __builtin_amdgcn_s_sleep(1); \
    if ((++_sp & 255u) == 0u) { if (xb_ld(&(bar)[XB_TMO])) break; if (_sp > XB_SPIN_CAP) { atomicAdd(&(bar)[XB_TMO], 1u); break; } } } } while (0)

struct XcdBarrier {
    unsigned* bar; unsigned x;
    volatile LAS unsigned* st;
};

__device__ __forceinline__ XcdBarrier xcd_barrier_post(unsigned* bar, volatile LAS unsigned* st) {
    XcdBarrier b; b.bar = bar; b.x = xb_xcc_id(); b.st = st;
    if (threadIdx.x == 0) (void)xb_add(&bar[XB_XCNT(b.x)], 1u);
    return b;
}
__device__ __forceinline__ void xcd_barrier_complete(unsigned* bar, unsigned x, unsigned& nloc, unsigned& nx) {
    const unsigned G = gridDim.x * gridDim.y * gridDim.z;
    unsigned sum, cnt, mine, sp = 0u;
    for (;;) {
        sum = 0u; cnt = 0u; mine = 0u;
#pragma unroll
        for (unsigned j = 0; j < 16; ++j) { const unsigned c = xb_ld(&bar[XB_XCNT(j)]); sum += c; cnt += (c > 0u) ? 1u : 0u; mine = (j == x) ? c : mine; }
        if (sum == G) break;
        __builtin_amdgcn_s_sleep(1);
        if ((++sp & 255u) == 0u) { if (xb_ld(&bar[XB_TMO])) break; if (sp > XB_SPIN_CAP) { atomicAdd(&bar[XB_TMO], 1u); break; } }
    }
    nloc = mine > 0u ? mine : 1u; nx = cnt > 0u ? cnt : 1u;
}

__device__ __forceinline__ void xcd_barrier(const XcdBarrier& b) {
    asm volatile("s_waitcnt vmcnt(0)" ::: "memory");
    __syncthreads();
    if (threadIdx.x == 0) {
        unsigned* bar = b.bar;
        __builtin_amdgcn_s_waitcnt(0);
        unsigned nloc = b.st[0], nx = b.st[1];
        if (nloc == 0u) { xcd_barrier_complete(bar, b.x, nloc, nx); b.st[0] = nloc; b.st[1] = nx; }
        const unsigned old = xb_add(&bar[XB_XSUB(b.x)], 1u);
        const unsigned gen = old / nloc;
        if (old + 1u == (gen + 1u) * nloc) {
            __builtin_amdgcn_fence(__ATOMIC_RELEASE, "agent");
            asm volatile("s_waitcnt vmcnt(0)" ::: "memory");
            const unsigned og = xb_add(&bar[XB_TOP], 1u);
            const unsigned tg = og / nx;
            if (og + 1u == (tg + 1u) * nx) xb_add(&bar[XB_TOPGEN], 1u);
            else XB_SPIN(xb_ld(&bar[XB_TOPGEN]) == tg, bar);
            __builtin_amdgcn_fence(__ATOMIC_ACQUIRE, "agent");
            xb_add(&bar[XB_XGEN(b.x)], 1u);
            asm volatile("s_waitcnt vmcnt(0)" ::: "memory");
        } else {
            XB_SPIN(xb_ld(&bar[XB_XGEN(b.x)]) == gen, bar);
            __builtin_amdgcn_fence(__ATOMIC_ACQUIRE, "agent");
            asm volatile("s_waitcnt vmcnt(0)" ::: "memory");
        }
    }
    __syncthreads();
}

DI void sb_unit(const bf16_t* QKV, bf16_t* ATT, LAS unsigned char* lds3, int b, int head, int qb, int wid, int lane) {
    const int r32 = lane & 31, hi = lane >> 5;
    const size_t rowbase = (size_t)b * SEQ;
    const int q0 = qb * 256 + wid * 32;
    const int qcol = head * 64, kcol = 512 + head * 64, vcol = 1024 + head * 64;
    bf16x8 qf[4];
#pragma unroll
    for (int c = 0; c < 4; ++c) qf[c] = *(const bf16x8*)(QKV + (rowbase + q0 + r32) * QKVW + qcol + 16 * c + 8 * hi);
    f32x16 o[2];
#pragma unroll
    for (int i = 0; i < 16; ++i) { o[0][i] = 0.f; o[1][i] = 0.f; }
    float carry = 0.f;
    LAS unsigned char* vimg = lds3 + wid * 4096;
    LAS unsigned char* vrd = vimg + (4 * hi + ((lane & 15) >> 2)) * 64 + ((lane >> 4) & 1) * 32 + (lane & 3) * 8;
    bf16x8 kf[4]; u32x4 vv[4];
#define SB_LOAD(K0) do { _Pragma("unroll") for (int c = 0; c < 4; ++c) kf[c] = *(const bf16x8*)(QKV + (rowbase + (K0) + r32) * QKVW + kcol + 16 * c + 8 * hi); \
        _Pragma("unroll") for (int i = 0; i < 4; ++i) { const int id = lane + 64 * i, key = id >> 3, ch = id & 7; vv[i] = *(const u32x4*)(QKV + (rowbase + (K0) + key) * QKVW + vcol + ch * 8); } } while (0)
    SB_LOAD(q0);
    for (int k0 = q0; k0 >= 0; k0 -= 32) {
        const bf16x8 kc0 = kf[0], kc1 = kf[1], kc2 = kf[2], kc3 = kf[3];
#pragma unroll
        for (int i = 0; i < 4; ++i) { const int id = lane + 64 * i, key = id >> 3, ch = id & 7; *(LAS u32x4*)(vimg + (ch >> 2) * 2048 + key * 64 + (ch & 3) * 16) = vv[i]; }
        if (k0 >= 32) SB_LOAD(k0 - 32);
        f32x16 s;
#pragma unroll
        for (int i = 0; i < 16; ++i) s[i] = 0.f;
        s = mfma32(kc0, qf[0], s); s = mfma32(kc1, qf[1], s); s = mfma32(kc2, qf[2], s); s = mfma32(kc3, qf[3], s);
        const int qpos = q0 + r32;
        float lk[16];
#pragma unroll
        for (int i = 0; i < 16; ++i) {
            const float z = s[i] * 0.125f;
            const bool past = (k0 + crow(i, hi)) < qpos;
            const float sp = fmaxf(z, 0.f) + __logf(1.f + __expf(-fabsf(z)));
            lk[i] = past ? -sp : 0.f;
            s[i] = past ? z : -INFINITY;
        }
        float gs[4], go[4];
#pragma unroll
        for (int g = 0; g < 4; ++g) { gs[g] = (lk[4 * g] + lk[4 * g + 1]) + (lk[4 * g + 2] + lk[4 * g + 3]); go[g] = xhalf(gs[g]); }
        const float ps0 = gs[0] + go[0], ps1 = gs[1] + go[1], ps2 = gs[2] + go[2], ps3 = gs[3] + go[3];
        float ap[4]; ap[3] = 0.f; ap[2] = ps3; ap[1] = ps3 + ps2; ap[0] = ps3 + ps2 + ps1;
#pragma unroll
        for (int g = 0; g < 4; ++g) {
            const float aft = carry + ap[g] + (hi == 0 ? go[g] : 0.f);
            const float w3 = aft, w2 = aft + lk[4 * g + 3], w1 = w2 + lk[4 * g + 2], w0 = w1 + lk[4 * g + 1];
            s[4 * g + 3] = __expf(s[4 * g + 3] + lk[4 * g + 3] + w3);
            s[4 * g + 2] = __expf(s[4 * g + 2] + lk[4 * g + 2] + w2);
            s[4 * g + 1] = __expf(s[4 * g + 1] + lk[4 * g + 1] + w1);
            s[4 * g + 0] = __expf(s[4 * g + 0] + lk[4 * g + 0] + w0);
        }
        carry += (ps0 + ps1) + (ps2 + ps3);
        const bf16x8 p0 = packP<0>(s), p1 = packP<1>(s);
        asm volatile("s_waitcnt lgkmcnt(0)" ::: "memory");
#pragma unroll
        for (int dt = 0; dt < 2; ++dt) {
            const bf16x8 v0 = vfrag(vrd + dt * 2048), v1 = vfrag(vrd + dt * 2048 + 1024);
            o[dt] = mfma32(v0, p0, o[dt]); o[dt] = mfma32(v1, p1, o[dt]);
        }
        asm volatile("s_waitcnt lgkmcnt(0)" ::: "memory");
        if (__all(carry < -104.f)) break;
    }
#undef SB_LOAD
    bf16_t* op = ATT + (rowbase + q0 + r32) * DM + head * 64;
#pragma unroll
    for (int dt = 0; dt < 2; ++dt)
#pragma unroll
        for (int g = 0; g < 4; ++g) { u32x2 w; w.x = pk_bf16(o[dt][4 * g], o[dt][4 * g + 1]); w.y = pk_bf16(o[dt][4 * g + 2], o[dt][4 * g + 3]); *(u32x2*)(op + 32 * dt + 8 * g + 4 * hi) = w; }
}

constexpr int DF_STAGE = 32768, DF_K2 = 8192, DF_V = 16384;
DI void glds16s(const void* sbase, unsigned voff, unsigned lds_dst) { unsigned keep;
    asm volatile("s_mov_b32 %0, m0\n\ts_mov_b32 m0, %3\n\ts_nop 0\n\tglobal_load_lds_dwordx4 %1, %2\n\ts_mov_b32 m0, %0" : "=&s"(keep) : "v"(voff), "s"(sbase), "s"(lds_dst) : "memory"); }
#define DF_VLD(VF, VOFF, H) do { _Pragma("unroll") for (int d2 = 0; d2 < 2; ++d2) { LAS unsigned char* vb_ = lds3 + (VOFF) + (2 * (H) + d2) * 4096; VF[2 * d2] = vfrag(vb_); VF[2 * d2 + 1] = vfrag(vb_ + 1024); } } while (0)
#define DF_PVM(VF, P0, P1, H) do { _Pragma("unroll") for (int d2 = 0; d2 < 2; ++d2) { o[2 * (H) + d2] = mfma32(VF[2 * d2], P0, o[2 * (H) + d2]); o[2 * (H) + d2] = mfma32(VF[2 * d2 + 1], P1, o[2 * (H) + d2]); } } while (0)
DI void diff_stage(const unsigned char* lds, LAS unsigned char* lds3, int buf, int t, int comp, int q0, int r32, int hi, int vlane, bool skew,
                   const bf16x8 (&qf)[4], f32x16 (&o)[4], float& m, float& l, bf16x8 (&pp)[4], int& pvo, bool& have_prev) {
    const int k0 = 64 * t;
    if (k0 > q0 + 31) return;
    const unsigned char* sb = lds + buf * DF_STAGE + comp * DF_K2 + r32 * 128; const int ke16 = (hi ^ ((r32 >> 1) & 7)) * 16;
    bf16x8 vf[4];
    if (skew && have_prev) {
#pragma unroll
        for (int sub = 0; sub < 2; ++sub) { DF_VLD(vf, pvo + sub * 2048, 0); DF_PVM(vf, pp[2 * sub], pp[2 * sub + 1], 0); DF_VLD(vf, pvo + sub * 2048, 1); DF_PVM(vf, pp[2 * sub], pp[2 * sub + 1], 1); }
    }
    f32x16 s0, s1;
#pragma unroll
    for (int i = 0; i < 16; ++i) { s0[i] = 0.f; s1[i] = 0.f; }
    {
        bf16x8 k0f[4], k1f[4];
#pragma unroll
        for (int c = 0; c < 4; ++c) { k0f[c] = *(const bf16x8*)(sb + ((32 * c) ^ ke16)); k1f[c] = *(const bf16x8*)(sb + 32 * 128 + ((32 * c) ^ ke16)); }
#pragma unroll
        for (int c = 0; c < 4; ++c) { s0 = mfma32(k0f[c], qf[c], s0); s1 = mfma32(k1f[c], qf[c], s1); }
    }
    if (k0 + 63 > q0) {
        const int dq = q0 + r32 - k0 - 4 * hi;
#pragma unroll
        for (int i = 0; i < 16; ++i) { const int ci = (i & 3) + 8 * (i >> 2); s0[i] = (ci > dq) ? -INFINITY : s0[i]; s1[i] = (ci + 32 > dq) ? -INFINITY : s1[i]; }
    }
    float mx = fmaxf(fmaxf(s0[0], s0[1]), s1[0]);
#pragma unroll
    for (int i = 1; i < 15; i += 2) { mx = fmaxf(fmaxf(mx, s0[i + 1]), s0[i + 2 > 15 ? 15 : i + 2]); mx = fmaxf(fmaxf(mx, s1[i]), s1[i + 1]); }
    mx = fmaxf(mx, s1[15]);
    mx = fmaxf(mx, xhalf(mx)) * SCL2;
    if (__any(mx > m + 8.f)) {
        const float mn = fmaxf(m, mx), al = fexp2(m - mn); l *= al; m = mn;
#pragma unroll
        for (int dt = 0; dt < 4; ++dt)
#pragma unroll
            for (int i = 0; i < 16; ++i) o[dt][i] *= al;
    }
    float sum0 = 0.f, sum1 = 0.f;
#pragma unroll
    for (int i = 0; i < 16; ++i) { s0[i] = fexp2(__builtin_fmaf(s0[i], SCL2, -m)); sum0 += s0[i]; s1[i] = fexp2(__builtin_fmaf(s1[i], SCL2, -m)); sum1 += s1[i]; }
    l += sum0 + sum1;
    const int vo = buf * DF_STAGE + DF_V + vlane;
    if (!skew) {
        const bf16x8 p00 = packP<0>(s0), p01 = packP<1>(s0);
        DF_VLD(vf, vo, 0); DF_PVM(vf, p00, p01, 0); DF_VLD(vf, vo, 1); DF_PVM(vf, p00, p01, 1);
        const bf16x8 p10 = packP<0>(s1), p11 = packP<1>(s1);
        DF_VLD(vf, vo + 2048, 0); DF_PVM(vf, p10, p11, 0); DF_VLD(vf, vo + 2048, 1); DF_PVM(vf, p10, p11, 1);
    } else { pp[0] = packP<0>(s0); pp[1] = packP<1>(s0); pp[2] = packP<0>(s1); pp[3] = packP<1>(s1); pvo = vo; have_prev = true; }
}
DI void diff_unit(const Args& A, const bf16_t* QKV, bf16_t* ATT, unsigned char* lds, LAS unsigned char* lds3, int b, int head, int qb, int tid, int wid, int lane) {
    const int r32 = lane & 31, hi = lane >> 5, comp = wid >> 2, wq = wid & 3;
    const size_t rowbase = (size_t)b * SEQ;
    const int q0 = qb * 128 + wq * 32;
    const int qcol = 1536 + head * 128 + comp * 64;
    bf16x8 qf[4];
#pragma unroll
    for (int c = 0; c < 4; ++c) qf[c] = *(const bf16x8*)(QKV + (rowbase + q0 + r32) * QKVW + qcol + 16 * c + 8 * hi);
    f32x16 o[4];
#pragma unroll
    for (int t = 0; t < 4; ++t)
#pragma unroll
        for (int i = 0; i < 16; ++i) o[t][i] = 0.f;
    float m = -INFINITY, l = 0.f;
    const int nst = 2 * (qb + 1);
    const unsigned ldsb = (unsigned)(uintptr_t)lds3;
    const int kkey = 8 * wid + (lane >> 3), kch = (lane & 7) ^ ((kkey >> 1) & 7);
    const int vi0 = 2 * wid, vi1 = 2 * wid + 1;
    const bf16_t* sbase = QKV + rowbase * QKVW + head * 128;
    const unsigned oK = (unsigned)((kkey * QKVW + 2048 + kch * 8) * 2);
    const unsigned oV0 = (unsigned)(((16 * (vi0 & 3) + (lane >> 2)) * QKVW + 2560 + ((vi0 >> 2) * 4 + (lane & 3)) * 8) * 2);
    const unsigned oV1 = (unsigned)(((16 * (vi1 & 3) + (lane >> 2)) * QKVW + 2560 + ((vi1 >> 2) * 4 + (lane & 3)) * 8) * 2);
    const unsigned dK = (unsigned)__builtin_amdgcn_readfirstlane(wid * 1024);
    const unsigned dV0 = (unsigned)__builtin_amdgcn_readfirstlane(DF_V + (vi0 >> 2) * 4096 + (vi0 & 3) * 1024), dV1 = (unsigned)__builtin_amdgcn_readfirstlane(DF_V + (vi1 >> 2) * 4096 + (vi1 & 3) * 1024);
#define DF_DMA(t, bufi) do { const bf16_t* sb_ = sbase + (size_t)(64 * (t)) * QKVW; const unsigned base_ = (unsigned)__builtin_amdgcn_readfirstlane(ldsb + (bufi) * DF_STAGE); \
        glds16s(sb_, oK, base_ + dK); glds16s(sb_, oK + 128u, base_ + DF_K2 + dK); glds16s(sb_, oV0, base_ + dV0); glds16s(sb_, oV1, base_ + dV1); } while (0)
#define DF_WAITBAR(N) asm volatile("s_waitcnt vmcnt(" #N ") lgkmcnt(0)\n\ts_barrier" ::: "memory")
    DF_DMA(0, 0); DF_DMA(1, 1);
    asm volatile("" : "+v"(qf[0]), "+v"(qf[1]), "+v"(qf[2]), "+v"(qf[3]));
    DF_WAITBAR(4);
    const int vlane = (4 * hi + ((lane & 15) >> 2)) * 64 + ((lane >> 4) & 1) * 32 + (lane & 3) * 8;
    const bool skew = false;
    bf16x8 pp[4]; { const bf16x8 z8 = {0, 0, 0, 0, 0, 0, 0, 0}; pp[0] = z8; pp[1] = z8; pp[2] = z8; pp[3] = z8; } int pvo = vlane; bool have_prev = false;
    for (int t = 0; t < nst; ++t) {
        { const int tl = (t + 2 < nst) ? t + 2 : nst - 1; DF_DMA(tl, (t + 2) & 3); }
        diff_stage(lds, lds3, t & 3, t, comp, q0, r32, hi, vlane, skew, qf, o, m, l, pp, pvo, have_prev);
        DF_WAITBAR(4);
    }
    asm volatile("s_waitcnt vmcnt(0)" ::: "memory");
#undef DF_DMA
#undef DF_WAITBAR
    if (skew && have_prev) { bf16x8 vf[4];
#pragma unroll
        for (int sub = 0; sub < 2; ++sub) { DF_VLD(vf, pvo + sub * 2048, 0); DF_PVM(vf, pp[2 * sub], pp[2 * sub + 1], 0); DF_VLD(vf, pvo + sub * 2048, 1); DF_PVM(vf, pp[2 * sub], pp[2 * sub + 1], 1); } }
    __syncthreads();
    float lam;
    {
        const float* lq1 = A.in[6] + head * 64; const float* lk1 = A.in[7] + head * 64; const float* lq2 = A.in[8] + head * 64; const float* lk2 = A.in[9] + head * 64;
        const float d1 = wave_sum(lq1[lane] * lk1[lane]), d2 = wave_sum(lq2[lane] * lk2[lane]);
        lam = __expf(d1) - __expf(d2) + 0.2f;
    }
    const float inv = 1.f / (l + xhalf(l));
    float* X = (float*)lds;
    if (comp == 1) {
#pragma unroll
        for (int t = 0; t < 4; ++t)
#pragma unroll
            for (int i = 0; i < 16; ++i) X[(wq * 64 + t * 16 + i) * 64 + lane] = o[t][i] * inv;
    }
    __syncthreads();
    if (comp == 0) {
        float ss = 0.f;
#pragma unroll
        for (int t = 0; t < 4; ++t)
#pragma unroll
            for (int i = 0; i < 16; ++i) { const float v = o[t][i] * inv - lam * X[(wq * 64 + t * 16 + i) * 64 + lane]; o[t][i] = v; ss += v * v; }
        ss += xhalf(ss);
        const float r = 0.8f / sqrtf(ss * (1.f / 128.f) + NORM_EPS);
        const float* g = A.in[10];
        bf16_t* op = ATT + (rowbase + q0 + r32) * DM + 512 + head * 128;
#pragma unroll
        for (int t = 0; t < 4; ++t)
#pragma unroll
            for (int gq = 0; gq < 4; ++gq) {
                const int d = 32 * t + 8 * gq + 4 * hi; const f32x4 gg = *(const f32x4*)(g + d);
                u32x2 w; w.x = pk_bf16(o[t][4 * gq] * r * gg.x, o[t][4 * gq + 1] * r * gg.y); w.y = pk_bf16(o[t][4 * gq + 2] * r * gg.z, o[t][4 * gq + 3] * r * gg.w);
                *(u32x2*)(op + d) = w;
            }
    }
    __syncthreads();
}
#undef DF_VLD
#undef DF_PVM

DI void phase_attn0(const Args& A, unsigned char* lds, LAS unsigned char* lds3, int tid, int wid, int lane) {
    const bf16_t* QKV = (const bf16_t*)(A.ws + WS_QKV); bf16_t* ATT = (bf16_t*)(A.ws + WS_ATT);
    const int G = gridDim.x;
    for (int pi = blockIdx.x; pi < 512; pi += G) {
        const int pid = (G == 256) ? ((pi & 7) * 64 + ((pi >> 3) & 31) + (pi >> 8) * 32) : pi;
        const int bh = pid >> 6, s = pid & 63, b = bh >> 2, head = bh & 3;
        diff_unit(A, QKV, ATT, lds, lds3, b, head, 127 - s, tid, wid, lane);
        diff_unit(A, QKV, ATT, lds, lds3, b, head, s, tid, wid, lane);
    }
}
DI void phase_attn0_sb(const Args& A, LAS unsigned char* lds3, int wid, int lane) {
    const bf16_t* QKV = (const bf16_t*)(A.ws + WS_QKV); bf16_t* ATT = (bf16_t*)(A.ws + WS_ATT);
    const int G = gridDim.x;
    for (int u = blockIdx.x; u < 1024; u += G) {
        const int bh = u >> 6, qb = u & 63, b = bh >> 3, head = bh & 7;
        sb_unit(QKV, ATT, lds3, b, head, qb, wid, lane);
    }
}


DI void phase_kmean(const Args& A, int gw, int ngw, int lane) {
    const bf16_t* QKV = (const bf16_t*)(A.ws + WS_QKV); float* KM = (float*)(A.ws + WS_KM);
    for (int u = gw; u < BATCH * 16 * 64; u += ngw) {
        const int blk = u & 63, bh = u >> 6, b = bh >> 4, h = bh & 15;
        const int ch = lane & 7, sub = lane >> 3;
        float acc[8];
#pragma unroll
        for (int k = 0; k < 8; ++k) acc[k] = 0.f;
        const bf16_t* base = QKV + ((size_t)b * SEQ + blk * 256 + sub) * QKVW + 1024 + h * 64 + ch * 8;
#pragma unroll 4
        for (int it = 0; it < 32; ++it) {
            const u32x4 w = *(const u32x4*)(base + (size_t)it * 8 * QKVW);
            acc[0] += bf_lo(w.x); acc[1] += bf_hi(w.x); acc[2] += bf_lo(w.y); acc[3] += bf_hi(w.y); acc[4] += bf_lo(w.z); acc[5] += bf_hi(w.z); acc[6] += bf_lo(w.w); acc[7] += bf_hi(w.w);
        }
#pragma unroll
        for (int k = 0; k < 8; ++k) { float v = acc[k]; v += __shfl_xor(v, 8); v += __shfl_xor(v, 16); v += __shfl_xor(v, 32); acc[k] = v * (1.f / 256.f); }
        if (lane < 8) { float* o = KM + (size_t)u * 64 + ch * 8; *(f32x4*)o = (f32x4){acc[0], acc[1], acc[2], acc[3]}; *(f32x4*)(o + 4) = (f32x4){acc[4], acc[5], acc[6], acc[7]}; }
    }
}
DI void top3_insert(float v, int idx, float& v1, int& i1, float& v2, int& i2, float& v3, int& i3) {
    const bool b1 = (v > v1) || (v == v1 && idx < i1), b2 = (v > v2) || (v == v2 && idx < i2), b3 = (v > v3) || (v == v3 && idx < i3);
    const float nv3 = b2 ? v2 : (b3 ? v : v3), nv2 = b1 ? v1 : (b2 ? v : v2), nv1 = b1 ? v : v1;
    const int ni3 = b2 ? i2 : (b3 ? idx : i3), ni2 = b1 ? i1 : (b2 ? idx : i2), ni1 = b1 ? idx : i1;
    v1 = nv1; v2 = nv2; v3 = nv3; i1 = ni1; i2 = ni2; i3 = ni3;
}
DI void phase_gate(const Args& A, int gw, int ngw, int lane) {
    const bf16_t* QKV = (const bf16_t*)(A.ws + WS_QKV); const float* KM = (const float*)(A.ws + WS_KM); unsigned* SEL = (unsigned*)(A.ws + WS_SEL);
    const int r32 = lane & 31, hi = lane >> 5;
    for (int u = gw; u < BATCH * 16 * 512; u += ngw) {
        const int qt = u & 511, bh = u >> 9, b = bh >> 4, h = bh & 15;
        const int own = qt >> 3;
        const size_t srow = (size_t)bh * SEQ + qt * 32 + r32;
        if (own == 0) { if (hi == 0) SEL[srow] = 0xffffffffu; continue; }
        bf16x8 qf[4];
#pragma unroll
        for (int c = 0; c < 4; ++c) qf[c] = *(const bf16x8*)(QKV + ((size_t)b * SEQ + qt * 32 + r32) * QKVW + h * 64 + 16 * c + 8 * hi);
        float v1 = -INFINITY, v2 = -INFINITY, v3 = -INFINITY; int i1 = 255, i2 = 255, i3 = 255;
        const int nmt = (own + 31) >> 5;
        for (int mt = 0; mt < nmt; ++mt) {
            f32x16 acc;
#pragma unroll
            for (int i = 0; i < 16; ++i) acc[i] = 0.f;
#pragma unroll
            for (int c = 0; c < 4; ++c) {
                const float* kp = KM + ((size_t)bh * 64 + 32 * mt + r32) * 64 + 16 * c + 8 * hi;
                const f32x4 x0 = *(const f32x4*)kp, x1 = *(const f32x4*)(kp + 4);
                u32x4 wh, wl;
                wh.x = pk_bf16(x0[0], x0[1]); wh.y = pk_bf16(x0[2], x0[3]); wh.z = pk_bf16(x1[0], x1[1]); wh.w = pk_bf16(x1[2], x1[3]);
                wl.x = pk_bf16(x0[0] - bf_lo(wh.x), x0[1] - bf_hi(wh.x)); wl.y = pk_bf16(x0[2] - bf_lo(wh.y), x0[3] - bf_hi(wh.y));
                wl.z = pk_bf16(x1[0] - bf_lo(wh.z), x1[1] - bf_hi(wh.z)); wl.w = pk_bf16(x1[2] - bf_lo(wh.w), x1[3] - bf_hi(wh.w));
                acc = mfma32(__builtin_bit_cast(bf16x8, wh), qf[c], acc);
                acc = mfma32(__builtin_bit_cast(bf16x8, wl), qf[c], acc);
            }
#pragma unroll
            for (int i = 0; i < 16; ++i) { const int blk = 32 * mt + crow(i, hi); const bool ok = blk < own; top3_insert(ok ? acc[i] : -INFINITY, ok ? blk : 255, v1, i1, v2, i2, v3, i3); }
        }
        const float ov1 = xhalf(v1), ov2 = xhalf(v2), ov3 = xhalf(v3);
        const int oi1 = __shfl_xor(i1, 32), oi2 = __shfl_xor(i2, 32), oi3 = __shfl_xor(i3, 32);
        top3_insert(ov1, oi1, v1, i1, v2, i2, v3, i3);
        top3_insert(ov2, oi2, v1, i1, v2, i2, v3, i3);
        top3_insert(ov3, oi3, v1, i1, v2, i2, v3, i3);
        if (hi == 0) SEL[srow] = (unsigned)i1 | ((unsigned)i2 << 8) | ((unsigned)i3 << 16) | 0xff000000u;
    }
}
constexpr int MB_K = 0, MB_V = 36864, MB_LIST = 69632, MB_MISC = 102400;
DI void moba_tile(const unsigned char* lds, LAS unsigned char* lds3, const bf16x8 (&qf)[4], int nsub, int diag_sub, int lane, f32x16 (&o)[2], float& m, float& l) {
    const int r32 = lane & 31, hi = lane >> 5;
    const int vlane = (4 * hi + ((lane & 15) >> 2)) * 64 + ((lane >> 4) & 1) * 32 + (lane & 3) * 8;
    for (int kk = 0; kk < nsub; ++kk) {
        bf16x8 kf[4], vf[4];
#pragma unroll
        for (int c = 0; c < 4; ++c) kf[c] = *(const bf16x8*)(lds + MB_K + (32 * kk + r32) * 144 + (16 * c + 8 * hi) * 2);
#pragma unroll
        for (int dt = 0; dt < 2; ++dt) { LAS unsigned char* vb = lds3 + MB_V + dt * 16384 + (32 * kk) * 64 + vlane; vf[2 * dt] = vfrag(vb); vf[2 * dt + 1] = vfrag(vb + 1024); }
        f32x16 s;
#pragma unroll
        for (int i = 0; i < 16; ++i) s[i] = 0.f;
#pragma unroll
        for (int c = 0; c < 4; ++c) s = mfma32(kf[c], qf[c], s);
        if (kk == diag_sub) {
            const int dq = r32 - 4 * hi;
#pragma unroll
            for (int i = 0; i < 16; ++i) s[i] = (((i & 3) + 8 * (i >> 2)) > dq) ? -INFINITY : s[i];
        }
        float mx = fmaxf(fmaxf(s[0], s[1]), s[2]);
#pragma unroll
        for (int i = 3; i < 15; i += 2) mx = fmaxf(fmaxf(mx, s[i]), s[i + 1]);
        mx = fmaxf(mx, s[15]);
        mx = fmaxf(mx, xhalf(mx)) * SCL2;
        const bool trig = mx > m + 8.f;
        if (__any(trig)) {
            const float mn = trig ? mx : m, al = fexp2(m - mn); l *= al; m = mn;
#pragma unroll
            for (int dt = 0; dt < 2; ++dt)
#pragma unroll
                for (int i = 0; i < 16; ++i) o[dt][i] *= al;
        }
        float sum = 0.f;
#pragma unroll
        for (int i = 0; i < 16; ++i) { s[i] = fexp2(__builtin_fmaf(s[i], SCL2, -m)); sum += s[i]; }
        l += sum;
        const bf16x8 p0 = packP<0>(s), p1 = packP<1>(s);
#pragma unroll
        for (int dt = 0; dt < 2; ++dt) { o[dt] = mfma32(vf[2 * dt], p0, o[dt]); o[dt] = mfma32(vf[2 * dt + 1], p1, o[dt]); }
    }
}
DI void moba_stage_kv(const bf16_t* QKV, unsigned char* lds, int b, int h, int blk, int tid) {
    const bf16_t* kb = QKV + ((size_t)b * SEQ + blk * 256) * QKVW + 1024 + h * 64;
    const bf16_t* vb = QKV + ((size_t)b * SEQ + blk * 256) * QKVW + 2048 + h * 64;
    u32x4 kr[4], vr[4];
#pragma unroll
    for (int i = 0; i < 4; ++i) { const int id = tid + 512 * i, key = id >> 3, ch = id & 7; kr[i] = *(const u32x4*)(kb + (size_t)key * QKVW + ch * 8); vr[i] = *(const u32x4*)(vb + (size_t)key * QKVW + ch * 8); }
#pragma unroll
    for (int i = 0; i < 4; ++i) { const int id = tid + 512 * i, key = id >> 3, ch = id & 7; *(u32x4*)(lds + MB_K + key * 144 + ch * 16) = kr[i]; *(u32x4*)(lds + MB_V + (ch >> 2) * 16384 + key * 64 + (ch & 3) * 16) = vr[i]; }
}
DI void phase_moba_sel(const Args& A, unsigned char* lds, LAS unsigned char* lds3, int tid, int wid, int lane) {
    const bf16_t* QKV = (const bf16_t*)(A.ws + WS_QKV); const unsigned* SEL = (const unsigned*)(A.ws + WS_SEL);
    bf16_t* PO = (bf16_t*)(A.ws + WS_PO); float* PML = (float*)(A.ws + WS_PML);
    unsigned* ctr = (unsigned*)(A.ws + WS_CTL) + 64;
    volatile int* misc = (volatile int*)(lds + MB_MISC);
    unsigned short* list = (unsigned short*)(lds + MB_LIST);
    const int r32 = lane & 31, hi = lane >> 5;
    for (;;) {
        __syncthreads();
        if (tid == 0) { misc[0] = (int)atomicAdd(ctr, 1u); misc[1] = 0; }
        __syncthreads();
        const int u = misc[0];
        if (u >= 63 * 32) break;
        const int j = u >> 5, bh = u & 31, b = bh >> 4, h = bh & 15;
        moba_stage_kv(QKV, lds, b, h, j, tid);
        const unsigned* selp = SEL + (size_t)bh * SEQ;
        for (int s0 = (j + 1) * 256 + tid; s0 < SEQ; s0 += 8 * NTHR) {
            unsigned wv[8];
#pragma unroll
            for (int k = 0; k < 8; ++k) { const int s = s0 + k * NTHR; wv[k] = (s < SEQ) ? selp[s] : 0xffffffffu; }
#pragma unroll
            for (int k = 0; k < 8; ++k) {
                const int s = s0 + k * NTHR; const unsigned w = wv[k];
                int slot = -1;
                if ((int)(w & 255u) == j) slot = 0; else if ((int)((w >> 8) & 255u) == j) slot = 1; else if ((int)((w >> 16) & 255u) == j) slot = 2;
                if (slot >= 0) { const int pos = atomicAdd((int*)&misc[1], 1); list[pos] = (unsigned short)((s << 2) | slot); }
            }
        }
        __syncthreads();
        const int cnt = misc[1];
        const int ntile = (cnt + 31) >> 5;
        int entn = 0; bool validn = false; bf16x8 qn[4];
#define MS_QLOAD(TL) do { const int e_ = (TL) * 32 + r32; validn = e_ < cnt; entn = list[validn ? e_ : 0]; const int s_ = entn >> 2; \
        _Pragma("unroll") for (int c = 0; c < 4; ++c) qn[c] = *(const bf16x8*)(QKV + ((size_t)b * SEQ + s_) * QKVW + h * 64 + 16 * c + 8 * hi); } while (0)
        if (wid < ntile) MS_QLOAD(wid);
        for (int tl = wid; tl < ntile; tl += NWAVES) {
            const bool valid = validn; const int ent = entn;
            const int s = ent >> 2, slot = ent & 3;
            bf16x8 qf[4];
#pragma unroll
            for (int c = 0; c < 4; ++c) qf[c] = qn[c];
            { const int tn = (tl + NWAVES < ntile) ? tl + NWAVES : tl; MS_QLOAD(tn); }
            f32x16 o[2];
#pragma unroll
            for (int i = 0; i < 16; ++i) { o[0][i] = 0.f; o[1][i] = 0.f; }
            float m = -INFINITY, l = 0.f;
            moba_tile(lds, lds3, qf, 8, -1, lane, o, m, l);
            const float lt = l + xhalf(l), inv = 1.f / lt;
            if (valid) {
                const size_t pe = ((size_t)bh * SEQ + s) * 3 + slot;
                bf16_t* op = PO + pe * 64;
#pragma unroll
                for (int dt = 0; dt < 2; ++dt)
#pragma unroll
                    for (int gp = 0; gp < 2; ++gp) { u32x4 w; w.x = pk_bf16(o[dt][8 * gp] * inv, o[dt][8 * gp + 1] * inv); w.y = pk_bf16(o[dt][8 * gp + 2] * inv, o[dt][8 * gp + 3] * inv); w.z = pk_bf16(o[dt][8 * gp + 4] * inv, o[dt][8 * gp + 5] * inv); w.w = pk_bf16(o[dt][8 * gp + 6] * inv, o[dt][8 * gp + 7] * inv); *(u32x4*)(op + hi * 32 + dt * 16 + gp * 8) = w; }
                if (hi == 0) { typedef float f32x2_t __attribute__((ext_vector_type(2))); *(f32x2_t*)(PML + pe * 2) = (f32x2_t){m, lt}; }
            }
        }
    }
}
#undef MS_QLOAD
constexpr int MB_GRP = 69632;
DI void moba_stage_kv256(const bf16_t* QKV, unsigned char* ldsg, int b, int h, int blk, int ltid) {
    const bf16_t* kb = QKV + ((size_t)b * SEQ + blk * 256) * QKVW + 1024 + h * 64;
    const bf16_t* vb = QKV + ((size_t)b * SEQ + blk * 256) * QKVW + 2048 + h * 64;
    u32x4 r[8];
#pragma unroll
    for (int i = 0; i < 8; ++i) { const int id = ltid + 256 * i, key = id >> 3, ch = id & 7; r[i] = *(const u32x4*)(kb + (size_t)key * QKVW + ch * 8); }
#pragma unroll
    for (int i = 0; i < 8; ++i) { const int id = ltid + 256 * i, key = id >> 3, ch = id & 7; *(u32x4*)(ldsg + MB_K + key * 144 + ch * 16) = r[i]; }
#pragma unroll
    for (int i = 0; i < 8; ++i) { const int id = ltid + 256 * i, key = id >> 3, ch = id & 7; r[i] = *(const u32x4*)(vb + (size_t)key * QKVW + ch * 8); }
#pragma unroll
    for (int i = 0; i < 8; ++i) { const int id = ltid + 256 * i, key = id >> 3, ch = id & 7; *(u32x4*)(ldsg + MB_V + (ch >> 2) * 16384 + key * 64 + (ch & 3) * 16) = r[i]; }
}
DI void phase_moba_own(const Args& A, unsigned char* lds, LAS unsigned char* lds3, int tid, int wid, int lane) {
    const bf16_t* QKV = (const bf16_t*)(A.ws + WS_QKV); const unsigned* SEL = (const unsigned*)(A.ws + WS_SEL);
    const bf16_t* PO = (const bf16_t*)(A.ws + WS_PO); const float* PML = (const float*)(A.ws + WS_PML); bf16_t* ATT = (bf16_t*)(A.ws + WS_ATT);
    const int r32 = lane & 31, hi = lane >> 5, grp = wid >> 2, g4 = wid & 3;
    unsigned char* ldsg = lds + grp * MB_GRP; LAS unsigned char* lds3g = lds3 + grp * MB_GRP;
    for (int u0 = 2 * blockIdx.x; u0 < BATCH * 16 * 64; u0 += 2 * gridDim.x) {
        const int u = u0 + grp, i = u & 63, bh = u >> 6, b = bh >> 4, h = bh & 15;
        __syncthreads();
        moba_stage_kv256(QKV, ldsg, b, h, i, tid & 255);
        __syncthreads();
#pragma unroll 1
        for (int pass = 0; pass < 2; ++pass) {
            const int tile = pass == 0 ? g4 : 7 - g4;
            const int s = i * 256 + tile * 32 + r32;
            bf16x8 qf[4];
#pragma unroll
            for (int c = 0; c < 4; ++c) qf[c] = *(const bf16x8*)(QKV + ((size_t)b * SEQ + s) * QKVW + h * 64 + 16 * c + 8 * hi);
            f32x16 o[2];
#pragma unroll
            for (int k = 0; k < 16; ++k) { o[0][k] = 0.f; o[1][k] = 0.f; }
            float m = -INFINITY, l = 0.f;
            const unsigned w = SEL[(size_t)bh * SEQ + s];
            const size_t pe0 = ((size_t)bh * SEQ + s) * 3;
            float pm[3], pl[3]; u32x2 pw[3][8];
#pragma unroll
            for (int slot = 0; slot < 3; ++slot) {
                { typedef float f32x2_t __attribute__((ext_vector_type(2))); const f32x2_t ml = *(const f32x2_t*)(PML + (pe0 + slot) * 2); pm[slot] = ml.x; pl[slot] = ml.y; }
#pragma unroll
                for (int dt = 0; dt < 2; ++dt)
#pragma unroll
                    for (int gp = 0; gp < 2; ++gp) { const u32x4 q4 = *(const u32x4*)(PO + (pe0 + slot) * 64 + hi * 32 + dt * 16 + gp * 8); pw[slot][dt * 4 + 2 * gp] = (u32x2){q4.x, q4.y}; pw[slot][dt * 4 + 2 * gp + 1] = (u32x2){q4.z, q4.w}; }
            }
            moba_tile(ldsg, lds3g, qf, tile + 1, tile, lane, o, m, l);
            l += xhalf(l);
#pragma unroll
            for (int slot = 0; slot < 3; ++slot) {
                const int idx = (int)((w >> (8 * slot)) & 255u);
                if (idx != 255) {
                    const float mp = pm[slot], lp = pl[slot];
                    const float M = fmaxf(m, mp), a = fexp2(m - M), bq = fexp2(mp - M) * lp;
#pragma unroll
                    for (int dt = 0; dt < 2; ++dt)
#pragma unroll
                        for (int g = 0; g < 4; ++g) {
                            const u32x2 q2 = pw[slot][dt * 4 + g];
                            o[dt][4 * g] = o[dt][4 * g] * a + bf_lo(q2.x) * bq; o[dt][4 * g + 1] = o[dt][4 * g + 1] * a + bf_hi(q2.x) * bq;
                            o[dt][4 * g + 2] = o[dt][4 * g + 2] * a + bf_lo(q2.y) * bq; o[dt][4 * g + 3] = o[dt][4 * g + 3] * a + bf_hi(q2.y) * bq;
                        }
                    l = l * a + bq; m = M;
                }
            }
            const float inv = 1.f / l;
            bf16_t* op = ATT + ((size_t)b * SEQ + s) * DM + h * 64;
#pragma unroll
            for (int dt = 0; dt < 2; ++dt)
#pragma unroll
                for (int gp = 0; gp < 2; ++gp) {
                    const int g0 = 2 * gp, g1 = 2 * gp + 1;
                    const unsigned x0 = pk_bf16(o[dt][4 * g0] * inv, o[dt][4 * g0 + 1] * inv), x1 = pk_bf16(o[dt][4 * g0 + 2] * inv, o[dt][4 * g0 + 3] * inv);
                    const unsigned y0 = pk_bf16(o[dt][4 * g1] * inv, o[dt][4 * g1 + 1] * inv), y1 = pk_bf16(o[dt][4 * g1 + 2] * inv, o[dt][4 * g1 + 3] * inv);
                    const auto r0 = __builtin_amdgcn_permlane32_swap(x0, y0, false, false), r1 = __builtin_amdgcn_permlane32_swap(x1, y1, false, false);
                    const u32x4 st = {r0[0], r1[0], r0[1], r1[1]};
                    *(u32x4*)(op + 32 * dt + 8 * (hi ? g1 : g0)) = st;
                }
        }
    }
}


#ifndef MK_MULTI
#define MK_MULTI 0
#endif
constexpr int NPHASE = 17;


__constant__ float ROPE_INV_FREQ[8] = {1.0f, 0.1939227432012558f, 0.03760603070259094f, 0.007292664609849453f, 0.0014142135623842478f, 0.00027424818836152554f, 5.3182957344688475e-05f, 1.0313385246263351e-05f};

template <class Epi, bool ALIGN = true> DI void run_gemm(unsigned char* lds, const bf16_t* Am, const bf16_t* Bt, int N, int K, const Epi& E) {
    pg8::Gemm g{Am, Bt, NT, N, K}; pg8::StaticOrder S; S.init(NT, N, (int)gridDim.x, (int)blockIdx.x);
    pg8::gemm_phase<Epi, pg8::StaticOrder, ALIGN, true>((PG8_LAS unsigned char*)lds, g, S, E);
}

typedef const __attribute__((address_space(4))) Args* KArgsP;
DI const Args* kargs() {
#if defined(__HIP_DEVICE_COMPILE__)
    KArgsP p = (KArgsP)__builtin_amdgcn_kernarg_segment_ptr(); asm volatile("" : "+s"(p)); return (const Args*)p;
#else
    return nullptr;
#endif
}
DI int otid() { int t = threadIdx.x; asm volatile("" : "+v"(t)); return t; }
#define CTX const Args A = *kargs(); const int tid = otid(), lane = tid & 63, wid = __builtin_amdgcn_readfirstlane(tid >> 6); LAS unsigned char* lds3 = (LAS unsigned char*)lds; \
    const int G = gridDim.x, gw = blockIdx.x * NWAVES + wid, ngw = G * NWAVES; unsigned char* ws = A.ws; float* out = A.out; (void)lane; (void)lds3; (void)gw; (void)ngw; (void)ws; (void)out; (void)G;

#define IN(k) (lo <= (k) && (k) < hi_ph)
#if MK_MULTI
#define SEAM(k) do { } while (0)
#else
#define SEAM(k) do { if (IN(k) && IN((k) + 1)) { if ((k) == 0) cg::this_grid().sync(); else { XcdBarrier xb_; xb_.bar = (unsigned*)(kargs()->ws + WS_CTL + CTL_BAR_OFF); xb_.x = xb_xcc_id(); xb_.st = (volatile LAS unsigned*)xb_st; xcd_barrier(xb_); } } } while (0)
#endif
#define WB(l) (ws + ((l) == 0 ? WS_WL0 : WS_WL1))
#define pU ((bf16_t*)(ws + WS_U))
#define pQKV ((bf16_t*)(ws + WS_QKV))
#define pATT ((bf16_t*)(ws + WS_ATT))
#define pHID ((bf16_t*)(ws + WS_HID))
#define pPP ((bf16_t*)(ws + WS_PP))
#define pROPE ((const float*)(ws + WS_ROPE))
#define pHB2 ((bf16_t*)out)
#define pPA ((float*)(ws + WS_PA))
#define pPB ((float*)(ws + WS_PB))
template <int l> DI void layer_phases(unsigned char* lds, unsigned* xb_st, const int lo, const int hi_ph) {
    int ph = (l == 0) ? 1 : 7;

        if (IN(ph)) { CTX EpiBf16R E{pQKV, QKVW, 0, l == 0 ? 6 : 0, l == 0 ? 10 : 8, pROPE, l == 0 ? pPA : pPB}; run_gemm(lds, l == 0 ? pU : pHB2, (const bf16_t*)(WB(l) + WO_IN), QKVW, DM, E); }
        SEAM(ph); ++ph;
        if (l == 0) {
            if (IN(ph)) { { CTX phase_attn0(A, lds, lds3, tid, wid, lane); } { CTX phase_attn0_sb(A, lds3, wid, lane); }
            }
            SEAM(ph); ++ph;
        } else {
            if (IN(ph)) { CTX phase_kmean(A, gw, ngw, lane); }
            SEAM(ph); ++ph;
            if (IN(ph)) { CTX phase_gate(A, gw, ngw, lane); }
            SEAM(ph); ++ph;
            if (IN(ph)) { CTX phase_moba_sel(A, lds, lds3, tid, wid, lane); }
            SEAM(ph); ++ph;
            if (IN(ph)) { CTX phase_moba_own(A, lds, lds3, tid, wid, lane); }
            SEAM(ph); ++ph;
        }
        if (IN(ph)) { CTX __syncthreads(); if (l == 0) { EpiRes<false> E{A.in[0], pU, pPA, DM}; run_gemm(lds, pATT, (const bf16_t*)(WB(l) + WO_OUT), DM, DM, E); } else { EpiRes<true> E{pHB2, pU, pPA, DM}; run_gemm(lds, pATT, (const bf16_t*)(WB(l) + WO_OUT), DM, DM, E); } }
        SEAM(ph); ++ph;
        if (IN(ph)) { CTX EpiBf16R E{pHID, FF, 2, 0, 0, pROPE, pPA}; run_gemm(lds, pU, (const bf16_t*)(WB(l) + WO_1), FF, DM, E); }
        SEAM(ph); ++ph;
        if (IN(ph)) { CTX EpiRes<true> E{pU, pU, pPA, DM}; run_gemm(lds, pHID, (const bf16_t*)(WB(l) + WO_2), DM, FF, E); }
        SEAM(ph); ++ph;
        if (IN(ph)) {
            { CTX EpiBf16R E{pPP, DM, 0, 0, 0, pROPE, nullptr}; run_gemm(lds, (const bf16_t*)(ws + (l == 0 ? WS_PB0 : WS_PB1)), (const bf16_t*)(WB(l) + WO_P), DM, PLE, E); }
            __threadfence(); __syncthreads();
            { CTX EpiPle E{pU, pPP, pPA, l == 0 ? pHB2 : pATT, pPB, DM}; run_gemm(lds, pU, (const bf16_t*)(WB(l) + WO_G), DM, DM, E); }
        }
        SEAM(ph); ++ph;
        if (l == 1) {
            if (IN(ph)) { CTX for (int m = gw; m < NT; m += ngw) final_row(pATT + (size_t)m * DM, pPB + (size_t)m * 16, A.in[19], out + (size_t)m * DM, lane); }
            ++ph;
        }
    }

__global__ void __launch_bounds__(NTHR, 2) mega_fwd(Args KA) {
    __shared__ __attribute__((aligned(16))) unsigned char lds[139264];
    const int lo = KA.ph_lo, hi_ph = KA.ph_hi;
    __shared__ __attribute__((aligned(16))) unsigned xb_st[4];
#if !MK_MULTI
    if (threadIdx.x < 4) xb_st[threadIdx.x] = 0u;
    __syncthreads();
    (void)xcd_barrier_post((unsigned*)(kargs()->ws + WS_CTL + CTL_BAR_OFF), (volatile LAS unsigned*)xb_st);
#endif
    if (IN(0)) {
        CTX
        float* scr = (float*)(lds + wid * 17408);
#pragma unroll
        for (int l = 0; l < 2; ++l) {
            unsigned char* wb = ws + (l == 0 ? WS_WL0 : WS_WL1);
            const float* srcs[6] = {A.in[l == 0 ? 4 : 11], A.in[l == 0 ? 5 : 12], A.in[14] + (size_t)l * DM * FF, A.in[15] + (size_t)l * FF * DM, A.in[17] + (size_t)l * DM * DM, A.in[18] + (size_t)l * PLE * DM};
            const int Ks[6] = {DM, DM, DM, FF, DM, PLE}, Ns[6] = {QKVW, DM, FF, DM, DM, DM};
            const float* gs[6] = {A.in[3] + l * DM, nullptr, A.in[13] + l * DM, nullptr, A.in[16] + l * DM, nullptr};
            const size_t offs[6] = {WO_IN, WO_OUT, WO_1, WO_2, WO_G, WO_P};
#pragma unroll
            for (int w = 0; w < 6; ++w) {
                const int nitems = (Ks[w] / 64) * (Ns[w] / 64);
                for (int it = gw; it < nitems; it += ngw) transpose_item(srcs[w], gs[w], Ks[w], Ns[w], (bf16_t*)(wb + offs[w]), scr, it, lane);
            }
        }
        {
            float* rope = (float*)(ws + WS_ROPE); const int* pos = (const int*)A.in[2];
            for (int idx = blockIdx.x * NTHR + tid; idx < NT * 8; idx += G * NTHR) {
                const int row = idx >> 3, i = idx & 7;
                const float ang = (float)pos[row] * ROPE_INV_FREQ[i];
                const double rev = (double)ang * 0.15915494309189535; const float fr = (float)(rev - rint(rev));
                rope[(size_t)row * 16 + i] = __builtin_amdgcn_cosf(fr); rope[(size_t)row * 16 + 8 + i] = __builtin_amdgcn_sinf(fr);
            }
        }
        {
            const float* p = A.in[1];
            constexpr int NG = 2 * NT * PLE / 8, HALF = NT * PLE / 8;
            for (int idx0 = blockIdx.x * NTHR + tid; idx0 < NG; idx0 += 4 * G * NTHR) {
                f32x4 a[4], b[4];
#pragma unroll
                for (int k = 0; k < 4; ++k) { const int idx = idx0 + k * G * NTHR; if (idx < NG) { a[k] = *(const f32x4*)(p + (size_t)idx * 8); b[k] = *(const f32x4*)(p + (size_t)idx * 8 + 4); } }
#pragma unroll
                for (int k = 0; k < 4; ++k) { const int idx = idx0 + k * G * NTHR; if (idx < NG) {
                    const int l = idx / HALF, r = idx % HALF;
                    u32x4 w; w.x = pk_bf16(a[k].x, a[k].y); w.y = pk_bf16(a[k].z, a[k].w); w.z = pk_bf16(b[k].x, b[k].y); w.w = pk_bf16(b[k].z, b[k].w);
                    *(u32x4*)((bf16_t*)(ws + (l == 0 ? WS_PB0 : WS_PB1)) + (size_t)r * 8) = w; } }
            }
        }
        {
            const float* x = A.in[0]; bf16_t* hb = (bf16_t*)(ws + WS_U); float* pa = (float*)(ws + WS_PA);
            for (int m = gw; m < NT; m += 2 * ngw) {
                const int m2 = m + ngw;
                const f32x4* xr = (const f32x4*)(x + (size_t)m * DM) + lane; const f32x4* xr2 = (const f32x4*)(x + (size_t)(m2 < NT ? m2 : m) * DM) + lane;
                f32x4 v[4], v2[4];
#pragma unroll
                for (int j = 0; j < 4; ++j) { v[j] = xr[64 * j]; v2[j] = xr2[64 * j]; }
                float s = 0.f, s2 = 0.f;
#pragma unroll
                for (int j = 0; j < 4; ++j) { s += (v[j].x * v[j].x + v[j].y * v[j].y) + (v[j].z * v[j].z + v[j].w * v[j].w); s2 += (v2[j].x * v2[j].x + v2[j].y * v2[j].y) + (v2[j].z * v2[j].z + v2[j].w * v2[j].w); }
                s = wave_sum(s); s2 = wave_sum(s2);
                u32x2* o8 = (u32x2*)(hb + (size_t)m * DM) + lane;
#pragma unroll
                for (int j = 0; j < 4; ++j) { u32x2 w; w.x = pk_bf16(v[j].x, v[j].y); w.y = pk_bf16(v[j].z, v[j].w); o8[64 * j] = w; }
                if (lane < 16) pa[(size_t)m * 16 + lane] = (lane == 0) ? s : 0.f;
                if (m2 < NT) {
                    u32x2* o82 = (u32x2*)(hb + (size_t)m2 * DM) + lane;
#pragma unroll
                    for (int j = 0; j < 4; ++j) { u32x2 w; w.x = pk_bf16(v2[j].x, v2[j].y); w.y = pk_bf16(v2[j].z, v2[j].w); o82[64 * j] = w; }
                    if (lane < 16) pa[(size_t)m2 * 16 + lane] = (lane == 0) ? s2 : 0.f;
                }
            }
        }
    }
    SEAM(0);
    layer_phases<0>(lds, xb_st, lo, hi_ph);
    layer_phases<1>(lds, xb_st, lo, hi_ph);
#undef IN
#undef SEAM
}

extern "C" void kernel_launch(void* const* d_in, const int* in_sizes, int n_in, void* d_out, int out_size, void* d_ws, size_t ws_size, hipStream_t stream) {
    static int grid = 0;
    if (grid == 0) {
        if (n_in != 20 || out_size != NT * DM || ws_size < WS_END) { fprintf(stderr, "kernel_launch: unexpected shapes (n_in %d, out %d, ws %zu < %zu); nothing launched\n", n_in, out_size, ws_size, (size_t)WS_END); grid = -1; return; }
        int dev = 0, cus = 0, per_cu = 0;
        hipGetDevice(&dev);
        hipDeviceGetAttribute(&cus, hipDeviceAttributeMultiprocessorCount, dev);
        hipOccupancyMaxActiveBlocksPerMultiprocessor(&per_cu, (const void*)mega_fwd, NTHR, 0);
        if (per_cu < 1) { fprintf(stderr, "kernel_launch: occupancy query says %d blocks per CU\n", per_cu); per_cu = 1; }
        grid = cus;
        (void)hipGetLastError();
    }
    if (grid < 0) return;
    hipMemsetAsync((char*)d_ws + WS_CTL, 0, CTL_BYTES, stream);
    Args a{};
    for (int i = 0; i < 20; ++i) a.in[i] = (const float*)d_in[i];
    a.out = (float*)d_out; a.ws = (unsigned char*)d_ws;
#if MK_MULTI
    for (int p = 0; p < NPHASE; ++p) { a.ph_lo = p; a.ph_hi = p + 1; hipLaunchKernelGGL(mega_fwd, dim3(grid), dim3(NTHR), 0, stream, a); }
#else
    a.ph_lo = 0; a.ph_hi = NPHASE;
    void* args[] = {&a};
    hipError_t e = hipLaunchCooperativeKernel((const void*)mega_fwd, dim3(grid), dim3(NTHR), args, 0, stream);
    if (e != hipSuccess) fprintf(stderr, "kernel_launch: cooperative launch failed: %s (grid %d)\n", hipGetErrorString(e), grid);
#endif
}
```
